# Optimizing an MI355X kernel written in HIP

```python
import math
import jax, jax.numpy as jnp
from jax import lax
import numpy as np

D_MODEL = 1024
BATCH = 2
SEQ = 16384
DEPTH = 2
DEC_BATCH = 32
DEC_SEQ = 2048
PAST_LEN = 128

N_EVEN = (DEPTH + 1) // 2
N_ODD = DEPTH // 2
D_FF = 4 * D_MODEL
NORM_EPS = 1e-6

N_BUCKETS = 32
MAX_DISTANCE = 128
N_BIAS_HEADS = 8

A_HEADS = 4
A_DIM = D_MODEL // (4 * A_HEADS)
A_VDIM = 2 * A_DIM
A_WIDTH = A_HEADS * A_VDIM
Q_BLOCK = 128
DIFF_SUBLN_EPS = 1e-5

B_HEADS = 4
B_DIM = D_MODEL // (2 * B_HEADS)
B_WIDTH = B_HEADS * B_DIM
RET_CHUNK = 128
ROPE_BASE = 10000.0

C_HEAD = 64
C_HEADS = (D_MODEL // 2) // C_HEAD
C_WIDTH = C_HEADS * C_HEAD
DECAY_LORA = 64
AAA_LORA = 64
GATE_LORA = 128
C_SPLITS = [C_WIDTH, C_WIDTH, C_WIDTH, DECAY_LORA, AAA_LORA, GATE_LORA]
C_COLS = sum(C_SPLITS)
RWKV_LN_EPS = 64e-5

D_QHEADS = 8
D_KVHEADS = 2
D_GROUP = D_QHEADS // D_KVHEADS
D_DIM = (D_MODEL // 2) // D_QHEADS
D_WIDTH = D_QHEADS * D_DIM
D_KV = D_KVHEADS * D_DIM
WINDOW = 128

EVEN_SPLITS = [A_WIDTH, A_WIDTH, A_WIDTH, B_WIDTH, B_WIDTH, B_WIDTH, B_WIDTH]
EVEN_COLS = sum(EVEN_SPLITS)
ODD_SPLITS = [C_COLS, D_WIDTH, D_KV, D_KV]
ODD_COLS = sum(ODD_SPLITS)
MIX_OUT_EVEN = A_WIDTH + B_WIDTH
MIX_OUT_ODD = C_WIDTH + D_WIDTH

kernel_name = "hybrid_bidir_encoder_diffattn_retnet_rwkv7_swa"


def _split(p, sizes):
    idx = np.cumsum(sizes)[:-1].tolist()
    return jnp.split(p, idx, axis=-1)


def rms_norm(x, g, eps=NORM_EPS):
    xf = x.astype(jnp.float32)
    y = xf * lax.rsqrt(jnp.mean(xf * xf, axis=-1, keepdims=True) + eps)
    return (y * g.astype(jnp.float32)).astype(x.dtype)


def t5_bucket(rel):
    half = N_BUCKETS // 2
    exact = half // 2
    ret = jnp.where(rel > 0, half, 0).astype(jnp.int32)
    n = jnp.abs(rel)
    nf = jnp.maximum(n, 1).astype(jnp.float32)
    large = exact + (jnp.log(nf / exact) / math.log(MAX_DISTANCE / exact) * (half - exact)).astype(jnp.int32)
    large = jnp.minimum(large, half - 1)
    return ret + jnp.where(n < exact, n, large)


def rope(x, pos):
    half = x.shape[-1] // 2
    freq = 1.0 / (ROPE_BASE ** (jnp.arange(half, dtype=jnp.float32) / half))
    ang = pos[:, None] * freq[None, :]
    cos = jnp.cos(ang)[None, :, None, :]
    sin = jnp.sin(ang)[None, :, None, :]
    x1, x2 = x[..., :half], x[..., half:]
    return jnp.concatenate([x1 * cos - x2 * sin, x1 * sin + x2 * cos], axis=-1)


def diff_attention(q, k, v, lam, subln, rel_bias, layer_idx):
    B, S, H, _, d = q.shape
    f32 = jnp.float32
    lam_init = 0.8 - 0.6 * math.exp(-0.3 * layer_idx)
    lam = lam.astype(f32)
    lam_full = jnp.exp(jnp.sum(lam[0] * lam[1])) - jnp.exp(jnp.sum(lam[2] * lam[3])) + lam_init
    nb = S // Q_BLOCK
    qb = jnp.moveaxis((q * (d ** -0.5)).reshape(B, nb, Q_BLOCK, H, 2, d), 1, 0)
    starts = jnp.arange(nb, dtype=jnp.int32) * Q_BLOCK
    key_pos = jnp.arange(S, dtype=jnp.int32)
    table = rel_bias.astype(f32)

    def block(args):
        qi, start = args
        s = jnp.einsum('bqhjd,bkhjd->bhjqk', qi, k).astype(f32)
        rel = key_pos[None, :] - (start + jnp.arange(Q_BLOCK, dtype=jnp.int32))[:, None]
        bias = table[t5_bucket(rel)].reshape(Q_BLOCK, S, H, 2).transpose(2, 3, 0, 1)
        p = jax.nn.softmax(s + bias, axis=-1)
        attn = p[:, :, 0] - lam_full * p[:, :, 1]
        return jnp.einsum('bhqk,bkhe->bqhe', attn.astype(v.dtype), v)

    o = lax.map(block, (qb, starts))
    o = jnp.moveaxis(o, 0, 1).reshape(B, S, H, 2 * d)
    o = rms_norm(o, subln, DIFF_SUBLN_EPS).astype(f32) * (1.0 - lam_init)
    return o.reshape(B, S, H * 2 * d)


def retention(q, k, v, g, decay_raw):
    f32 = jnp.float32
    B, S, H, dk = q.shape
    dv = v.shape[-1]
    pos = jnp.arange(S, dtype=f32)
    q = rope(q.astype(f32), pos)
    k = rope(k.astype(f32), pos) * (dk ** -0.5)
    v = v.astype(f32)
    log_g = -jax.nn.softplus(decay_raw.astype(f32))
    nc = S // RET_CHUNK

    def to_chunks(t):
        z = jnp.stack([t, t[:, ::-1]])
        return jnp.moveaxis(z.reshape(2, B, nc, RET_CHUNK, H, t.shape[-1]), 2, 0)

    qz, kz, vz = to_chunks(q), to_chunks(k), to_chunks(v)
    idx = jnp.arange(RET_CHUNK, dtype=f32)
    diff = idx[:, None] - idx[None, :]
    dmat = jnp.where(diff >= 0, jnp.exp(log_g[:, :, None, None] * jnp.maximum(diff, 0.0)), 0.0)
    xi = jnp.exp(log_g[:, :, None] * (idx + 1.0)).transpose(0, 2, 1)[:, None, :, :, None]
    zeta = jnp.exp(log_g[:, :, None] * (RET_CHUNK - 1.0 - idx)).transpose(0, 2, 1)[:, None, :, :, None]
    g_chunk = jnp.exp(log_g * RET_CHUNK)[:, None, :, None, None]

    def step(R, inp):
        qc, kc, vc = inp
        s = jnp.einsum('zbchd,zbehd->zbhce', qc, kc) * dmat[:, None]
        intra = jnp.einsum('zbhce,zbehv->zbchv', s, vc)
        cross = jnp.einsum('zbchd,zbhdv->zbchv', qc, R) * xi
        R = R * g_chunk + jnp.einsum('zbchd,zbchv->zbhdv', kc, vc * zeta)
        return R, intra + cross

    R0 = jnp.zeros((2, B, H, dk, dv), f32)
    _, o = lax.scan(step, R0, (qz, kz, vz))
    o = jnp.moveaxis(o, 0, 2).reshape(2, B, S, H, dv)
    y = o[0] + o[1][:, ::-1]
    y = y * lax.rsqrt(jnp.mean(y * y, axis=-1, keepdims=True) + NORM_EPS)
    y = jax.nn.silu(g.astype(f32)) * y
    return y.reshape(B, S, H * dv)


def rwkv7_bidir(pc, mu, w0, w2, a0, a2, g2, k_k, k_a, r_k, ln_w, ln_b):
    f32 = jnp.float32
    B, S, _ = pc.shape
    pc = pc.astype(f32)
    mu = mu.astype(f32)
    zero = jnp.zeros_like(pc[:, :1])
    prev = jnp.concatenate([zero, pc[:, :-1]], axis=1)
    nxt = jnp.concatenate([pc[:, 1:], zero], axis=1)
    pc = pc + mu[0] * (prev - pc) + mu[1] * (nxt - pc)
    r, k, v, zw, za, zg = _split(pc, C_SPLITS)
    w_log = -jax.nn.softplus(-(w0.astype(f32)[:, None, None, :]
                               + jnp.einsum('bsr,zrc->zbsc', jnp.tanh(zw), w2.astype(f32)))) - 0.5
    decay = jnp.exp(-jnp.exp(w_log))
    a = jax.nn.sigmoid(a0.astype(f32)[:, None, None, :] + jnp.einsum('bsr,zrc->zbsc', za, a2.astype(f32)))
    g = jax.nn.sigmoid(zg) @ g2.astype(f32)

    def hs(t):
        return t.reshape(t.shape[:-1] + (C_HEADS, C_HEAD))

    r, k, v, decay, a = hs(r), hs(k), hs(v), hs(decay), hs(a)
    kk = k * hs(k_k.astype(f32))
    kk = kk / jnp.maximum(jnp.sqrt(jnp.sum(kk * kk, axis=-1, keepdims=True)), 1e-12)
    k_mod = k[None] * (1.0 + (a - 1.0) * hs(k_a.astype(f32)))

    def both(t):
        return jnp.stack([t, t[:, ::-1]])

    def rev(t):
        return jnp.stack([t[0], t[1][:, ::-1]])

    kk_z = both(kk)
    xs = (both(r), rev(decay), rev(k_mod), both(v), -kk_z, kk_z * rev(a))
    xs = tuple(jnp.moveaxis(t, 2, 0) for t in xs)

    def step(state, inp):
        r_t, w_t, k_t, v_t, ka_t, kb_t = inp
        sa = jnp.einsum('zbhvk,zbhk->zbhv', state, ka_t)
        state = state * w_t[..., None, :] + sa[..., None] * kb_t[..., None, :] + v_t[..., None] * k_t[..., None, :]
        return state, jnp.einsum('zbhvk,zbhk->zbhv', state, r_t)

    state0 = jnp.zeros((2, B, C_HEADS, C_HEAD, C_HEAD), f32)
    _, ys = lax.scan(step, state0, xs)
    ys = jnp.moveaxis(ys, 0, 2)
    y = ys[0] + ys[1][:, ::-1]
    bonus = jnp.sum(r[None] * k_mod * r_k.astype(f32), axis=-1, keepdims=True) * v[None]
    y = y + bonus[0] + bonus[1]
    mean = jnp.mean(y, axis=-1, keepdims=True)
    var = jnp.mean(jnp.square(y - mean), axis=-1, keepdims=True)
    y = ((y - mean) * lax.rsqrt(var + RWKV_LN_EPS)).reshape(B, S, C_WIDTH)
    y = y * ln_w.astype(f32) + ln_b.astype(f32)
    return y * g


def window_gqa(q, k, v, sink, rel_bias):
    f32 = jnp.float32
    B, S, _, d = q.shape
    nb = S // WINDOW
    qb = jnp.moveaxis((q * (d ** -0.5)).reshape(B, nb, WINDOW, D_KVHEADS, D_GROUP, d), 1, 0)

    def windows(t):
        tp = jnp.pad(t, ((0, 0), (WINDOW, WINDOW), (0, 0), (0, 0))).reshape(B, nb + 2, WINDOW, D_KVHEADS, d)
        w = jnp.concatenate([tp[:, :-2], tp[:, 1:-1], tp[:, 2:]], axis=2)
        return jnp.moveaxis(w, 1, 0)

    kw, vw = windows(k), windows(v)
    rel = (jnp.arange(3 * WINDOW, dtype=jnp.int32)[None, :] - WINDOW) - jnp.arange(WINDOW, dtype=jnp.int32)[:, None]
    band = jnp.abs(rel) <= WINDOW
    bias = rel_bias.astype(f32)[t5_bucket(rel)].transpose(2, 0, 1).reshape(D_KVHEADS, D_GROUP, WINDOW, 3 * WINDOW)
    key_pos = jnp.arange(nb, dtype=jnp.int32)[:, None] * WINDOW - WINDOW + jnp.arange(3 * WINDOW, dtype=jnp.int32)[None, :]
    kval = (key_pos >= 0) & (key_pos < S)
    sink_l = sink.astype(f32).reshape(D_KVHEADS, D_GROUP)[:, :, None, None]

    def block(args):
        qi, ki, vi, kv_ok = args
        s = jnp.einsum('bqhgd,bkhd->bhgqk', qi, ki).astype(f32) + bias
        s = jnp.where(band & kv_ok[None, :], s, -jnp.inf)
        m = jnp.maximum(jnp.max(s, axis=-1, keepdims=True), sink_l)
        e = jnp.exp(s - m)
        p = e / (jnp.sum(e, axis=-1, keepdims=True) + jnp.exp(sink_l - m))
        return jnp.einsum('bhgqk,bkhd->bqhgd', p.astype(vi.dtype), vi)

    o = lax.map(block, (qb, kw, vw, kval))
    return jnp.moveaxis(o, 0, 1).reshape(B, S, D_WIDTH)


def even_mixer(h, P, i, layer):
    B, S, _ = h.shape
    p = h @ P["even_w_in"][i]
    qa, ka, va, qb, kb, vb, gb = _split(p, EVEN_SPLITS)
    ya = diff_attention(qa.reshape(B, S, A_HEADS, 2, A_DIM), ka.reshape(B, S, A_HEADS, 2, A_DIM),
                        va.reshape(B, S, A_HEADS, A_VDIM), P["diff_lambda"][i], P["diff_subln"][i],
                        P["rel_bias"], layer)
    yb = retention(qb.reshape(B, S, B_HEADS, B_DIM), kb.reshape(B, S, B_HEADS, B_DIM),
                   vb.reshape(B, S, B_HEADS, B_DIM), gb.reshape(B, S, B_HEADS, B_DIM), P["ret_decay"][i])
    y = jnp.concatenate([ya.astype(h.dtype), yb.astype(h.dtype)], axis=-1)
    return y @ P["even_w_out"][i]


def odd_mixer(h, P, i):
    B, S, _ = h.shape
    p = h @ P["odd_w_in"][i]
    pc, qd, kd, vd = _split(p, ODD_SPLITS)
    yc = rwkv7_bidir(pc, P["rwkv_mu"][i], P["rwkv_w0"][i], P["rwkv_w2"][i], P["rwkv_a0"][i], P["rwkv_a2"][i],
                     P["rwkv_g2"][i], P["rwkv_k_k"][i], P["rwkv_k_a"][i], P["rwkv_r_k"][i],
                     P["rwkv_ln_w"][i], P["rwkv_ln_b"][i])
    yd = window_gqa(qd.reshape(B, S, D_QHEADS, D_DIM), kd.reshape(B, S, D_KVHEADS, D_DIM),
                    vd.reshape(B, S, D_KVHEADS, D_DIM), P["swa_sink"][i], P["rel_bias"])
    y = jnp.concatenate([yc.astype(h.dtype), yd.astype(h.dtype)], axis=-1)
    return y @ P["odd_w_out"][i]


def sqrelu_mlp(h, w_up, w_down):
    return jnp.square(jax.nn.relu(h @ w_up)) @ w_down


def trunk(x, P):
    for layer in range(DEPTH):
        i = layer // 2
        h = rms_norm(x, P["norm_mix"][layer])
        if layer % 2 == 0:
            x = x + even_mixer(h, P, i, layer)
        else:
            x = x + odd_mixer(h, P, i)
        h = rms_norm(x, P["norm_ffn"][layer])
        x = x + sqrelu_mlp(h, P["ffn_up"][layer], P["ffn_down"][layer])
    return rms_norm(x, P["norm_final"])


def setup_inputs(seed: int = 0) -> dict:
    key = jax.random.key(seed)
    ks = jax.random.split(key, 32)
    f32 = jnp.float32

    def nrm(k, shape, scale):
        return scale * jax.random.normal(k, shape, f32)

    c = -np.log1p(-(2.0 ** (-5.0 - np.arange(B_HEADS))))
    raw0 = jnp.asarray(np.log(np.expm1(c)), dtype=f32)
    w0_base = jnp.tile(jnp.linspace(-6.0, 1.0, C_HEAD, dtype=f32), C_HEADS)
    return {
        "x_prompt": nrm(ks[0], (BATCH, SEQ, D_MODEL), 1.0),
        "x_sample": nrm(ks[1], (DEC_BATCH, DEC_SEQ, D_MODEL), 1.0),
        "rel_bias": nrm(ks[2], (N_BUCKETS, N_BIAS_HEADS), 0.5),
        "norm_mix": 1.0 + nrm(ks[3], (DEPTH, D_MODEL), 0.02),
        "norm_ffn": 1.0 + nrm(ks[4], (DEPTH, D_MODEL), 0.02),
        "norm_final": 1.0 + nrm(ks[5], (D_MODEL,), 0.02),
        "ffn_up": nrm(ks[6], (DEPTH, D_MODEL, D_FF), D_MODEL ** -0.5),
        "ffn_down": nrm(ks[7], (DEPTH, D_FF, D_MODEL), D_FF ** -0.5),
        "even_w_in": nrm(ks[8], (N_EVEN, D_MODEL, EVEN_COLS), D_MODEL ** -0.5),
        "even_w_out": nrm(ks[9], (N_EVEN, MIX_OUT_EVEN, D_MODEL), MIX_OUT_EVEN ** -0.5),
        "diff_lambda": nrm(ks[10], (N_EVEN, 4, A_DIM), 0.1),
        "diff_subln": 1.0 + nrm(ks[11], (N_EVEN, A_VDIM), 0.02),
        "ret_decay": raw0[None, None, :] + nrm(ks[12], (N_EVEN, 2, B_HEADS), 0.05),
        "odd_w_in": nrm(ks[13], (N_ODD, D_MODEL, ODD_COLS), D_MODEL ** -0.5),
        "odd_w_out": nrm(ks[14], (N_ODD, MIX_OUT_ODD, D_MODEL), MIX_OUT_ODD ** -0.5),
        "rwkv_mu": jax.random.uniform(ks[15], (N_ODD, 2, C_COLS), f32, 0.0, 0.5),
        "rwkv_w0": w0_base[None, None, :] + nrm(ks[16], (N_ODD, 2, C_WIDTH), 0.1),
        "rwkv_w2": nrm(ks[17], (N_ODD, 2, DECAY_LORA, C_WIDTH), 0.1),
        "rwkv_a0": nrm(ks[18], (N_ODD, 2, C_WIDTH), 0.1),
        "rwkv_a2": nrm(ks[19], (N_ODD, 2, AAA_LORA, C_WIDTH), 0.1),
        "rwkv_g2": nrm(ks[20], (N_ODD, GATE_LORA, C_WIDTH), GATE_LORA ** -0.5),
        "rwkv_k_k": 0.85 + nrm(ks[21], (N_ODD, C_WIDTH), 0.02),
        "rwkv_k_a": 1.0 + nrm(ks[22], (N_ODD, C_WIDTH), 0.02),
        "rwkv_r_k": nrm(ks[23], (N_ODD, C_HEADS, C_HEAD), 0.1),
        "rwkv_ln_w": 1.0 + nrm(ks[24], (N_ODD, C_WIDTH), 0.02),
        "rwkv_ln_b": nrm(ks[25], (N_ODD, C_WIDTH), 0.02),
        "swa_sink": nrm(ks[26], (N_ODD, D_QHEADS), 0.5),
    }


def reference(x_prompt, x_sample, rel_bias, norm_mix, norm_ffn, norm_final, ffn_up, ffn_down,
              even_w_in, even_w_out, diff_lambda, diff_subln, ret_decay,
              odd_w_in, odd_w_out, rwkv_mu, rwkv_w0, rwkv_w2, rwkv_a0, rwkv_a2, rwkv_g2,
              rwkv_k_k, rwkv_k_a, rwkv_r_k, rwkv_ln_w, rwkv_ln_b, swa_sink):
    P = {
        "rel_bias": rel_bias, "norm_mix": norm_mix, "norm_ffn": norm_ffn, "norm_final": norm_final,
        "ffn_up": ffn_up, "ffn_down": ffn_down,
        "even_w_in": even_w_in, "even_w_out": even_w_out, "diff_lambda": diff_lambda,
        "diff_subln": diff_subln, "ret_decay": ret_decay,
        "odd_w_in": odd_w_in, "odd_w_out": odd_w_out, "rwkv_mu": rwkv_mu, "rwkv_w0": rwkv_w0,
        "rwkv_w2": rwkv_w2, "rwkv_a0": rwkv_a0, "rwkv_a2": rwkv_a2, "rwkv_g2": rwkv_g2,
        "rwkv_k_k": rwkv_k_k, "rwkv_k_a": rwkv_k_a, "rwkv_r_k": rwkv_r_k,
        "rwkv_ln_w": rwkv_ln_w, "rwkv_ln_b": rwkv_ln_b, "swa_sink": swa_sink,
    }
    y_prompt = trunk(x_prompt, P)
    y_sample = trunk(x_sample, P)
    return (y_prompt, y_sample)
```

```cpp
#include <hip/hip_runtime.h>
#include <hip/hip_cooperative_groups.h>
#include <cstdio>
#include <cstdint>
namespace cg = cooperative_groups;

typedef unsigned short bf16_t;
typedef short bf16x8 __attribute__((ext_vector_type(8)));
typedef float f32x4 __attribute__((ext_vector_type(4)));
typedef float f32x2 __attribute__((ext_vector_type(2)));
typedef unsigned u32x4 __attribute__((ext_vector_type(4)));
typedef unsigned u32x2 __attribute__((ext_vector_type(2)));

constexpr int T = 98304, TP = 32768, DM = 1024, DFF = 4096;
constexpr int NSTRIPE = T / 96;
constexpr int NGC = T / 128;
constexpr size_t MiB = 1u << 20;
constexpr size_t WS_CTL = 0;
constexpr size_t WS_TAB = 64 * 1024;
constexpr size_t WS_ROPE = 1 * MiB;
constexpr size_t WS_ZG = 10 * MiB;
constexpr size_t WS_W = 24 * MiB;
constexpr size_t W_INE = WS_W;
constexpr size_t W_OUTE = W_INE + 7 * MiB;
constexpr size_t W_UP0 = W_OUTE + 2 * MiB;
constexpr size_t W_DN0 = W_UP0 + 16 * MiB;
constexpr size_t W_INO = W_DN0 + 16 * MiB;
constexpr size_t W_OUTO = W_INO + 5 * MiB;
constexpr size_t W_W2 = W_OUTO + 2 * MiB;
constexpr size_t W_A2 = W_W2 + 128 * 1024;
constexpr size_t W_G2 = W_A2 + 128 * 1024;
constexpr size_t WS_P = 80 * MiB;
constexpr size_t PE_SZ = 96 * MiB;
constexpr size_t P_QA = WS_P, P_KA = P_QA + PE_SZ, P_VTA = P_KA + PE_SZ, P_QB = P_VTA + PE_SZ, P_KB = P_QB + PE_SZ, P_VTB = P_KB + PE_SZ, P_GB = P_VTB + PE_SZ;
constexpr size_t P_PC = WS_P;
constexpr size_t P_QD = P_PC + 336 * MiB;
constexpr size_t P_KD = P_QD + 96 * MiB;
constexpr size_t P_VTD = P_KD + 24 * MiB;
constexpr size_t WS_YS = 560 * MiB;
constexpr size_t WS_Y = 752 * MiB;
constexpr size_t WS_END = 944 * MiB;
constexpr size_t HID_BLK = 96 * 2048 * 2;

constexpr int SMEM_BYTES = 77824;
constexpr int MAXGRID = 512;

struct Params {
  const float* in[27];
  float* out;
  unsigned char* ws;
  int ph_lo, ph_hi;
};

__device__ __forceinline__ unsigned f2bf(float f) { unsigned u = __builtin_bit_cast(unsigned, f); return (u + 0x7fffu + ((u >> 16) & 1u)) >> 16; }
typedef __bf16 bf2_t __attribute__((ext_vector_type(2)));
__device__ __forceinline__ unsigned pk2(float lo, float hi) { const f32x2 v = (f32x2){lo, hi}; const bf2_t b = __builtin_convertvector(v, bf2_t); return __builtin_bit_cast(unsigned, b); }
__device__ __forceinline__ float bf2f(unsigned short h) { return __builtin_bit_cast(float, (unsigned)h << 16); }
__device__ __forceinline__ float bflo(unsigned u) { return __builtin_bit_cast(float, u << 16); }
__device__ __forceinline__ float bfhi(unsigned u) { return __builtin_bit_cast(float, u & 0xffff0000u); }
__device__ __forceinline__ f32x4 mfma16(bf16x8 a, bf16x8 b, f32x4 c) { return __builtin_amdgcn_mfma_f32_16x16x32_bf16(a, b, c, 0, 0, 0); }
__device__ __forceinline__ float wave_sum(float v) {
#pragma unroll
  for (int o = 1; o < 64; o <<= 1) v += __shfl_xor(v, o);
  return v;
}
__device__ __forceinline__ int opaque_tid() { int t = threadIdx.x; asm volatile("" : "+v"(t)); return t; }
__device__ __forceinline__ void fence_sync() { __builtin_amdgcn_fence(__ATOMIC_RELEASE, "workgroup"); __syncthreads(); __builtin_amdgcn_fence(__ATOMIC_ACQUIRE, "workgroup"); }
__device__ __forceinline__ int seq_start(int t) { return t < TP ? (t & ~16383) : (TP + ((t - TP) & ~2047)); }
__device__ __forceinline__ int seq_len(int t) { return t < TP ? 16384 : 2048; }
__device__ __forceinline__ const float* xin_row(const Params& p, int t) { return t < TP ? p.in[0] + (size_t)t * DM : p.in[1] + (size_t)(t - TP) * DM; }

__device__ __forceinline__ void stage_rc(int b, int& R, int& C) { const int st = b / 1024, sb = b % 1024, swz = sb ^ (((sb >> 9) & 1) << 5); R = (st >> 1) * 16 + swz / 64; C = (st & 1) * 32 + (swz % 64) / 2; }
#define WAIT_V(n) asm volatile("s_waitcnt vmcnt(%0)" ::"n"(n) : "memory")
#define RAW_BARRIER() do { asm volatile("s_waitcnt lgkmcnt(0)" ::: "memory"); __builtin_amdgcn_s_barrier(); asm volatile("" ::: "memory"); } while (0)
template <class Epi>
__device__ __forceinline__ void gemm_multi(const bf16_t* __restrict__ A, size_t lda, const bf16_t* __restrict__ B0, size_t ldb, size_t bstride, int K, int NT, unsigned char* smem, Epi epi) {
  constexpr int STG = 24576;
  const int tid = opaque_tid(), lane = tid & 63, wid = tid >> 6, wr = wid >> 1, wc = wid & 1, fr = lane & 15, fq = lane >> 4;
  __builtin_amdgcn_sched_barrier(0);
  f32x4 acc[3][8];
#pragma unroll
  for (int m = 0; m < 3; ++m)
#pragma unroll
    for (int n = 0; n < 8; ++n) acc[m][n] = (f32x4){0.f, 0.f, 0.f, 0.f};
  const int nk = K >> 5, total = NT * nk;
  const int sb = lane * 16, swz = sb ^ (((sb >> 9) & 1) << 5), Rin = swz >> 6, Cin = (swz & 63) >> 1;
  const bool lowhalf = __builtin_amdgcn_readfirstlane(wid) < 2;
  const bf16_t* gA = A + (size_t)(wid * 16 + Rin) * lda + Cin;
  const bf16_t* gB = B0 + (size_t)(wid * 16 + Rin) * ldb + Cin;
  int ikt = 0;
#define GT_ISSUE(st_) do { unsigned char* d_ = smem + (st_) * STG + tid * 16; const int ko_ = ikt * 32; \
    __builtin_amdgcn_global_load_lds((const unsigned*)(gA + ko_), (unsigned*)(d_), 16, 0, 0); \
    if (lowhalf) __builtin_amdgcn_global_load_lds((const unsigned*)(gA + (size_t)64 * lda + ko_), (unsigned*)(d_ + 4096), 16, 0, 0); \
    _Pragma("unroll") for (int i = 0; i < 4; ++i) __builtin_amdgcn_global_load_lds((const unsigned*)(gB + (size_t)(64 * i) * ldb + ko_), (unsigned*)(d_ + 8192 + i * 4096), 16, 0, 0); \
    if (++ikt == nk) { ikt = 0; gB += bstride; } } while (0)
  GT_ISSUE(0);
  if (total > 1) { GT_ISSUE(1); if (lowhalf) WAIT_V(6); else WAIT_V(5); } else { WAIT_V(0); }
  RAW_BARRIER();
  const int foff = (fr * 64 + fq * 16) ^ ((fr >> 3) << 5);
  int st = 0, kt = 0, nt = 0;
#pragma unroll 1
  for (int g = 0; g < total; ++g) {
    if (g + 2 < total) { const int s2 = st == 0 ? 2 : st - 1; GT_ISSUE(s2); }
    const unsigned char* sA = smem + st * STG + foff;
    bf16x8 af[3], bfr[8];
#pragma unroll
    for (int m = 0; m < 3; ++m) af[m] = *(const bf16x8*)(sA + (wr * 3 + m) * 1024);
#pragma unroll
    for (int n = 0; n < 8; ++n) bfr[n] = *(const bf16x8*)(sA + (8 + wc * 8 + n) * 1024);
#pragma unroll
    for (int m = 0; m < 3; ++m)
#pragma unroll
      for (int n = 0; n < 8; ++n) acc[m][n] = mfma16(bfr[n], af[m], acc[m][n]);
    if (++kt == nk) {
#pragma unroll
      for (int m = 0; m < 3; ++m)
#pragma unroll
        for (int n = 0; n < 8; ++n) { epi(nt, wr * 48 + m * 16 + fr, wc * 128 + n * 16 + fq * 4, acc[m][n]); acc[m][n] = (f32x4){0.f, 0.f, 0.f, 0.f}; }
      kt = 0; ++nt;
    }
    if (g + 2 < total) { if (lowhalf) WAIT_V(6); else WAIT_V(5); } else WAIT_V(0);
    RAW_BARRIER();
    st = st == 2 ? 0 : st + 1;
  }
#undef GT_ISSUE
  __builtin_amdgcn_sched_barrier(0);
}
template <class Epi>
__device__ __forceinline__ void gemm_tile(const bf16_t* __restrict__ A, size_t lda, const bf16_t* __restrict__ B, size_t ldb, int K, unsigned char* smem, Epi epi) {
  gemm_multi(A, lda, B, ldb, 0, K, 1, smem, [&](int, int r, int c, f32x4 v) { epi(r, c, v); });
}

template <class Epi>
__device__ __forceinline__ void gemm192(const bf16_t* __restrict__ A, size_t lda, const bf16_t* __restrict__ Wsub  , int ldb  , int n0, int koff, int K, int NT, unsigned char* smem, Epi epi) {
  constexpr int STG = 28672;
  const int tid = opaque_tid(), lane = tid & 63, wid = tid >> 6, wr = wid >> 1, wc = wid & 1, fr = lane & 15, fq = lane >> 4;
  __builtin_amdgcn_sched_barrier(0);
  f32x4 acc[6][8];
#pragma unroll
  for (int m = 0; m < 6; ++m)
#pragma unroll
    for (int n = 0; n < 8; ++n) acc[m][n] = (f32x4){0.f, 0.f, 0.f, 0.f};
  const int nk = K >> 5, total = NT * nk;
  const int sb = lane * 16, swz = sb ^ (((sb >> 9) & 1) << 5), Rin = swz >> 6, Cin = (swz & 63) >> 1;
  const bf16_t* gA = A + (size_t)(wid * 16 + Rin) * lda + Cin;
  const size_t rb = (size_t)(ldb >> 5) * 1024;
  const int rot = (int)(((__builtin_amdgcn_s_getreg((3 << 11) | 20) & 7u) * (unsigned)NT) >> 3);
  const unsigned char* gB0 = (const unsigned char*)Wsub + ((size_t)(n0 >> 4) * (ldb >> 5) + (koff >> 5)) * 1024 + (size_t)wid * rb + lane * 16;
  int ikt = 0, itile = rot;
#define G192_ISSUE(st_) do { unsigned char* d_ = smem + (st_) * STG + tid * 16; const int ko_ = ikt * 32; \
    _Pragma("unroll") for (int i = 0; i < 3; ++i) __builtin_amdgcn_global_load_lds((const unsigned*)(gA + (size_t)(64 * i) * lda + ko_), (unsigned*)(d_ + i * 4096), 16, 0, 0); \
    { const unsigned char* tb_ = gB0 + (size_t)(itile * 16) * rb + (size_t)ikt * 1024; \
    _Pragma("unroll") for (int i = 0; i < 4; ++i) __builtin_amdgcn_global_load_lds((const unsigned*)(tb_ + (size_t)(4 * i) * rb), (unsigned*)(d_ + 12288 + i * 4096), 16, 0, 0); } \
    if (++ikt == nk) { ikt = 0; if (++itile == NT) itile = 0; } } while (0)
  G192_ISSUE(0);
  WAIT_V(0);
  RAW_BARRIER();
  const int foff = (fr * 64 + fq * 16) ^ ((fr >> 3) << 5);
  int st = 0, kt = 0, nt = rot;
#pragma unroll 1
  for (int g = 0; g < total; ++g) {
    if (g + 1 < total) G192_ISSUE(st ^ 1);
    const unsigned char* sA = smem + st * STG + foff;
    bf16x8 af[6];
#pragma unroll
    for (int m = 0; m < 6; ++m) af[m] = *(const bf16x8*)(sA + (wr * 6 + m) * 1024);
#pragma unroll
    for (int n = 0; n < 8; ++n) {
      const bf16x8 bfr = *(const bf16x8*)(sA + 12288 + (wc * 8 + n) * 1024);
#pragma unroll
      for (int m = 0; m < 6; ++m) acc[m][n] = mfma16(bfr, af[m], acc[m][n]);
    }
    if (++kt == nk) {
#pragma unroll
      for (int m = 0; m < 6; ++m) {
        int rr = wr * 96 + m * 16 + fr; asm volatile("" : "+v"(rr));
#pragma unroll
        for (int n = 0; n < 8; ++n) { epi(nt, rr, wc * 128 + n * 16 + fq * 4, acc[m][n]); acc[m][n] = (f32x4){0.f, 0.f, 0.f, 0.f}; }
        __builtin_amdgcn_sched_barrier(0);
      }
      kt = 0; if (++nt == NT) nt = 0;
    }
    WAIT_V(0);
    RAW_BARRIER();
    st ^= 1;
  }
#undef G192_ISSUE
  __builtin_amdgcn_sched_barrier(0);
}

template <bool SUB>
__device__ __forceinline__ void transpose_item(const float* __restrict__ W, int K, int N, bf16_t* __restrict__ WT, int item, unsigned char* smem) {
  float* s = (float*)smem;
  const int nb = N / 64, kb = item / nb, nn = item % nb, k0 = kb * 64, n0 = nn * 64, tid = threadIdx.x;
#pragma unroll 4
  for (int i = 0; i < 16; ++i) { const int kk = (tid >> 6) + 4 * i, n = tid & 63; s[kk * 65 + n] = W[(size_t)(k0 + kk) * N + n0 + n]; }
  __syncthreads();
  const int kq = tid & 7;
#pragma unroll
  for (int i = 0; i < 2; ++i) {
    const int n = (tid >> 3) + 32 * i;
    u32x4 o;
    o.x = pk2(s[(kq * 8 + 0) * 65 + n], s[(kq * 8 + 1) * 65 + n]); o.y = pk2(s[(kq * 8 + 2) * 65 + n], s[(kq * 8 + 3) * 65 + n]);
    o.z = pk2(s[(kq * 8 + 4) * 65 + n], s[(kq * 8 + 5) * 65 + n]); o.w = pk2(s[(kq * 8 + 6) * 65 + n], s[(kq * 8 + 7) * 65 + n]);
    if (!SUB) *(u32x4*)(WT + (size_t)(n0 + n) * K + k0 + kq * 8) = o;
    else {
      const int nn2 = n0 + n, kk2 = k0 + kq * 8, ob = (nn2 & 15) * 64 + (kk2 & 31) * 2, swz = ob ^ (((ob >> 9) & 1) << 5);
      *(u32x4*)((unsigned char*)WT + ((size_t)(nn2 >> 4) * (K >> 5) + (kk2 >> 5)) * 1024 + swz) = o;
    }
  }
  __syncthreads();
}

__device__ void phase0(const Params& p, unsigned char* smem) {
  unsigned char* ws = p.ws;
  int base = 0;
#define TJOB(SUB_, src_, K_, N_, dst_) do { const int ni = ((K_) / 64) * ((N_) / 64); int first = (int)blockIdx.x - (base % (int)gridDim.x); if (first < 0) first += gridDim.x; \
    for (int it = first; it < ni; it += gridDim.x) transpose_item<SUB_>((src_), (K_), (N_), (bf16_t*)(ws + (dst_)), it, smem); base += ni; } while (0)
  TJOB(true, p.in[8], 1024, 3584, W_INE);
  TJOB(true, p.in[9], 1024, 1024, W_OUTE);
  TJOB(true, p.in[6], 1024, 4096, W_UP0);
  TJOB(true, p.in[6] + (size_t)1024 * 4096, 1024, 4096, W_UP0 + 8 * MiB);
  TJOB(true, p.in[7], 4096, 1024, W_DN0);
  TJOB(true, p.in[7] + (size_t)4096 * 1024, 4096, 1024, W_DN0 + 8 * MiB);
  TJOB(true, p.in[13], 1024, 2560, W_INO);
  TJOB(true, p.in[14], 1024, 1024, W_OUTO);
  TJOB(false, p.in[17], 64, 512, W_W2);
  TJOB(false, p.in[17] + 64 * 512, 64, 512, W_W2 + 64 * 1024);
  TJOB(false, p.in[19], 64, 512, W_A2);
  TJOB(false, p.in[19] + 64 * 512, 64, 512, W_A2 + 64 * 1024);
  TJOB(false, p.in[20], 128, 512, W_G2);
#undef TJOB
  const int gt = blockIdx.x * 256 + threadIdx.x, gs = gridDim.x * 256;
  float* tab = (float*)(ws + WS_TAB);
  for (int i = gt; i < 2 * 8 * 513; i += gs) {
    const int which = i / (8 * 513), i2 = i % (8 * 513), hb = i2 / 513, rel = i2 % 513 - 256;
    const int n = rel < 0 ? -rel : rel;
    int b = rel > 0 ? 16 : 0;
    if (n < 8) b += n;
    else { const int large = 8 + ((31 - __clz(n * n)) - 6); b += large < 15 ? large : 15; }
    float v = p.in[2][b * 8 + hb] * 1.4426950408889634f;
    if (which == 1 && n > 128) v = -1e30f;
    tab[i] = v;
  }
  f32x2* cs = (f32x2*)(ws + WS_ROPE);
  for (int i = gt; i < 16384 * 64; i += gs) {
    const int pos = i >> 6, k = i & 63;
    const float freq = 1.0f / powf(10000.0f, (float)k / 64.0f);
    const float ang = (float)pos * freq;
    const double a = (double)ang;
    const double red = a - 6.283185307179586476925 * floor(a * 0.15915494309189533577);
    cs[i] = (f32x2){(float)cos(red), (float)sin(red)};
  }
}

template <int MODE>
__device__ __forceinline__ void norm_stripe(const Params& p, int t0, const float* __restrict__ g, bf16_t* H) {
  const int tid_ = opaque_tid(), lane = tid_ & 63, wid = tid_ >> 6;
  for (int rr = wid; rr < 96; rr += 4) {
    const int t = t0 + rr;
    const float* src = (MODE == 0) ? xin_row(p, t) : (p.out + (size_t)t * DM);
    f32x4 v[4]; float ss = 0.f;
#pragma unroll
    for (int i = 0; i < 4; ++i) { v[i] = *(const f32x4*)(src + (lane + 64 * i) * 4); ss += v[i].x * v[i].x + v[i].y * v[i].y + v[i].z * v[i].z + v[i].w * v[i].w; }
    ss = wave_sum(ss);
    const float rstd = 1.0f / sqrtf(ss * (1.0f / 1024.0f) + 1e-6f);
#pragma unroll
    for (int i = 0; i < 4; ++i) {
      const f32x4 gv = *(const f32x4*)(g + (lane + 64 * i) * 4);
      const f32x4 o = v[i] * rstd * gv;
      if (MODE == 2) *(f32x4*)(p.out + (size_t)t * DM + (lane + 64 * i) * 4) = o;
      else { u32x2 w; w.x = pk2(o.x, o.y); w.y = pk2(o.z, o.w); *(u32x2*)(H + (size_t)t * DM + (lane + 64 * i) * 4) = w; }
    }
  }
}

template <int NJ, int DVT, bool SWA, bool KSH = false>
__device__ __forceinline__ void attn_item(const bf16_t* __restrict__ Qg, int ldq, const bf16_t* __restrict__ Kg, int ldk, const bf16_t* __restrict__ VTg, int S,
                                          int q0, int kbeg, int kend, const float* __restrict__ tabg  ,
                                          unsigned char* smem, f32x4 (&o)[NJ][DVT], float (&lsum)[NJ]) {
  constexpr int CG = KSH ? 2 : 2 * NJ, NSUBK = 2 * CG, NSUB = NSUBK + DVT, PPT = NSUB / 4, STAGE = NSUB * 1024, TBBYTES = ((NJ * 513 * 4 + 255) / 256) * 256;
  const int tid = opaque_tid(), lane = tid & 63, wid = tid >> 6, fr = lane & 15, fq = lane >> 4;
  float* tb = (float*)smem;
  unsigned char* sbase = smem + TBBYTES;
  for (int i = tid; i < NJ * 513; i += 256) tb[i] = tabg[i];
  bf16x8 qf[NJ][2];
#pragma unroll
  for (int j = 0; j < NJ; ++j)
#pragma unroll
    for (int ks = 0; ks < 2; ++ks) qf[j][ks] = *(const bf16x8*)(Qg + (size_t)(q0 + 16 * wid + fr) * ldq + j * 64 + ks * 32 + fq * 8);
#pragma unroll
  for (int j = 0; j < NJ; ++j) {
    lsum[j] = 0.f;
#pragma unroll
    for (int n = 0; n < DVT; ++n) o[j][n] = (f32x4){0.f, 0.f, 0.f, 0.f};
  }
  const int qpos = q0 + 16 * wid + fr;
  const float c_scale = 0.125f * 1.4426950408889634f;
  const int ntile = (kend - kbeg) >> 5;
  const int sb = lane * 16, swz = sb ^ (((sb >> 9) & 1) << 5), Rin = swz >> 6, Cin = (swz & 63) >> 1;
  size_t goff[PPT]; bool isk[PPT];
#pragma unroll
  for (int i = 0; i < PPT; ++i) {
    const int sub = i * 4 + wid;
    isk[i] = sub < NSUBK;
    if (sub < NSUBK) { const int t4 = sub / CG, cg = sub % CG; goff[i] = (size_t)(4 * t4 + 8 * (Rin >> 2) + (Rin & 3)) * ldk + cg * 32 + Cin; }
    else goff[i] = (size_t)((sub - NSUBK) * 16 + Rin) * S + Cin;
  }
#define ATT_ISSUE(t_) do { const int k0_ = kbeg + (t_) * 32; unsigned char* d_ = sbase + ((t_) & 3) * STAGE + tid * 16; \
    _Pragma("unroll") for (int i = 0; i < PPT; ++i) { const bf16_t* g_ = isk[i] ? Kg + (size_t)k0_ * ldk + goff[i] : VTg + k0_ + goff[i]; \
      __builtin_amdgcn_global_load_lds((const unsigned*)g_, (unsigned*)(d_ + i * 4096), 16, 0, 0); } } while (0)
  ATT_ISSUE(0);
  if (ntile > 1) ATT_ISSUE(1);
  if (ntile > 2) ATT_ISSUE(2);
  if (ntile > 2) WAIT_V(2 * PPT); else if (ntile > 1) WAIT_V(PPT); else WAIT_V(0);
  RAW_BARRIER();
  const int foff = (fr * 64 + fq * 16) ^ ((fr >> 3) << 5);
#pragma unroll 1
  for (int kt = 0; kt < ntile; ++kt) {
    const int k0 = kbeg + kt * 32;
    if (kt + 3 < ntile) ATT_ISSUE(kt + 3);
    const unsigned char* sK = sbase + (kt & 3) * STAGE + foff;
    const unsigned char* sV = sK + NSUBK * 1024;
    const bool farL = (k0 + 31 - q0) <= -128, farR = (k0 - (q0 + 63)) >= 128;
    bf16x8 pb[NJ];
#pragma unroll
    for (int j = 0; j < NJ; ++j) {
      f32x4 s[2];
#pragma unroll
      for (int t4 = 0; t4 < 2; ++t4) {
        s[t4] = (f32x4){0.f, 0.f, 0.f, 0.f};
#pragma unroll
        for (int ks = 0; ks < 2; ++ks) {
          const bf16x8 kf = *(const bf16x8*)(sK + (t4 * CG + (KSH ? 0 : j * 2) + ks) * 1024);
          s[t4] = mfma16(kf, qf[j][ks], s[t4]);
        }
      }
      float ps = 0.f;
      if (!SWA && (farL || farR)) {
        const float b = farL ? tb[j * 513] : tb[j * 513 + 512];
#pragma unroll
        for (int t4 = 0; t4 < 2; ++t4)
#pragma unroll
          for (int r = 0; r < 4; ++r) { const float e = __builtin_amdgcn_exp2f(s[t4][r] * c_scale + b); s[t4][r] = e; ps += e; }
      } else {
        const float* tbj = tb + j * 513 + 256 + (k0 + 8 * fq - qpos);
#pragma unroll
        for (int t4 = 0; t4 < 2; ++t4)
#pragma unroll
          for (int r = 0; r < 4; ++r) { const float e = __builtin_amdgcn_exp2f(s[t4][r] * c_scale + tbj[4 * t4 + r]); s[t4][r] = e; ps += e; }
      }
      lsum[j] += ps;
      u32x4 w; w.x = pk2(s[0][0], s[0][1]); w.y = pk2(s[0][2], s[0][3]); w.z = pk2(s[1][0], s[1][1]); w.w = pk2(s[1][2], s[1][3]);
      pb[j] = __builtin_bit_cast(bf16x8, w);
    }
#pragma unroll
    for (int n = 0; n < DVT; ++n) {
      const bf16x8 vf = *(const bf16x8*)(sV + n * 1024);
#pragma unroll
      for (int j = 0; j < NJ; ++j) o[j][n] = mfma16(vf, pb[j], o[j][n]);
    }
    if (kt + 3 < ntile) WAIT_V(2 * PPT); else if (kt + 2 < ntile) WAIT_V(PPT); else WAIT_V(0);
    RAW_BARRIER();
  }
#undef ATT_ISSUE
#pragma unroll
  for (int j = 0; j < NJ; ++j) { lsum[j] += __shfl_xor(lsum[j], 16); lsum[j] += __shfl_xor(lsum[j], 32); }
}

__device__ void diff_item(const Params& p, int item, unsigned char* smem) {
  int seq, h, qt;
  if (item < 2048) { seq = item >> 10; h = (item >> 8) & 3; qt = item & 255; }
  else { const int i2 = item - 2048; seq = 2 + (i2 >> 7); h = (i2 >> 5) & 3; qt = i2 & 31; }
  const int S = seq < 2 ? 16384 : 2048, ts = seq < 2 ? seq * 16384 : TP + (seq - 2) * 2048;
  unsigned char* ws = p.ws;
  const bf16_t* Q = (const bf16_t*)(ws + P_QA) + (size_t)ts * 512 + h * 128;
  const bf16_t* Kp = (const bf16_t*)(ws + P_KA) + (size_t)ts * 512 + h * 128;
  const bf16_t* VT = (const bf16_t*)(ws + P_VTA) + (size_t)ts * 512 + (size_t)(h * 128) * S;
  const float* tab = (const float*)(ws + WS_TAB) + (h * 2) * 513;
  f32x4 o[2][8]; float l[2];
  attn_item<2, 8, false>(Q, 512, Kp, 512, VT, S, qt * 64, 0, S, tab, smem, o, l);
  const float* lam = p.in[10];
  float d0 = 0.f, d1 = 0.f;
  for (int i = 0; i < 64; ++i) { d0 += lam[i] * lam[64 + i]; d1 += lam[128 + i] * lam[192 + i]; }
  const float lam_init = 0.2f;
  const float lam_full = expf(d0) - expf(d1) + lam_init;
  const int tid_ = opaque_tid(), lane = tid_ & 63, wid = tid_ >> 6, fr = lane & 15, fq = lane >> 4;
  const float i0 = 1.0f / l[0], i1 = lam_full / l[1];
  float ss = 0.f;
#pragma unroll
  for (int n = 0; n < 8; ++n) { o[0][n] = o[0][n] * i0 - o[1][n] * i1; ss += o[0][n].x * o[0][n].x + o[0][n].y * o[0][n].y + o[0][n].z * o[0][n].z + o[0][n].w * o[0][n].w; }
  ss += __shfl_xor(ss, 16); ss += __shfl_xor(ss, 32);
  const float rstd = (1.0f - lam_init) / sqrtf(ss * (1.0f / 128.0f) + 1e-5f);
  const int t = ts + qt * 64 + 16 * wid + fr;
  bf16_t* Y = (bf16_t*)(ws + WS_Y) + (size_t)t * 1024 + h * 128;
  const float* sub = p.in[11];
#pragma unroll
  for (int n = 0; n < 8; ++n) {
    const f32x4 g = *(const f32x4*)(sub + n * 16 + fq * 4);
    const f32x4 v = o[0][n] * rstd * g;
    u32x2 w; w.x = pk2(v.x, v.y); w.y = pk2(v.z, v.w);
    *(u32x2*)(Y + n * 16 + fq * 4) = w;
  }
}

__device__ void swa_item(const Params& p, int item, unsigned char* smem) {
  const int kvh = item & 1, qtg = item >> 1;
  const int tq = qtg * 64, ts = seq_start(tq), S = seq_len(tq), q0 = tq - ts;
  unsigned char* ws = p.ws;
  const bf16_t* Q = (const bf16_t*)(ws + P_QD) + (size_t)ts * 512 + kvh * 256;
  const bf16_t* Kp = (const bf16_t*)(ws + P_KD) + (size_t)ts * 128 + kvh * 64;
  const bf16_t* VT = (const bf16_t*)(ws + P_VTD) + (size_t)ts * 128 + (size_t)(kvh * 64) * S;
  const float* tab = (const float*)(ws + WS_TAB) + (8 + kvh * 4) * 513;
  int kbeg = q0 - 128; if (kbeg < 0) kbeg = 0;
  int kend = q0 + 64 + 128; if (kend > S) kend = S;
  f32x4 o[4][4]; float l[4];
  attn_item<4, 4, true, true>(Q, 512, Kp, 128, VT, S, q0, kbeg, kend, tab, smem, o, l);
  const int tid_ = opaque_tid(), lane = tid_ & 63, wid = tid_ >> 6, fr = lane & 15, fq = lane >> 4;
  const int t = tq + 16 * wid + fr;
#pragma unroll
  for (int j = 0; j < 4; ++j) {
    const int hq = kvh * 4 + j;
    const float inv = 1.0f / (l[j] + expf(p.in[26][hq]));
    bf16_t* Y = (bf16_t*)(ws + WS_Y) + (size_t)t * 1024 + 512 + hq * 64;
#pragma unroll
    for (int n = 0; n < 4; ++n) {
      const f32x4 v = o[j][n] * inv;
      u32x2 w; w.x = pk2(v.x, v.y); w.y = pk2(v.z, v.w);
      *(u32x2*)(Y + n * 16 + fq * 4) = w;
    }
  }
}

constexpr int RS = 136;
__device__ __forceinline__ void lds_gemm128(f32x4 (&acc)[4][4], const unsigned char* sA, const unsigned char* sB) {
  const int tid_ = opaque_tid(), lane = tid_ & 63, wid = tid_ >> 6, wr = wid >> 1, wc = wid & 1, fr = lane & 15, fq = lane >> 4;
#pragma unroll
  for (int ks = 0; ks < 4; ++ks) {
    bf16x8 af[4], bfr[4];
#pragma unroll
    for (int m = 0; m < 4; ++m) af[m] = *(const bf16x8*)(sA + ((wr * 64 + m * 16 + fr) * RS + ks * 32 + fq * 8) * 2);
#pragma unroll
    for (int n = 0; n < 4; ++n) bfr[n] = *(const bf16x8*)(sB + ((wc * 64 + n * 16 + fr) * RS + ks * 32 + fq * 8) * 2);
#pragma unroll
    for (int m = 0; m < 4; ++m)
#pragma unroll
      for (int n = 0; n < 4; ++n) acc[m][n] = mfma16(bfr[n], af[m], acc[m][n]);
    __builtin_amdgcn_sched_barrier(0);
  }
}
template <bool TRANS, class F>
__device__ __forceinline__ void stage_rope(unsigned char* dst, const bf16_t* __restrict__ src, int pos0, const f32x2* __restrict__ cs, F tokscale) {
  const int tid = opaque_tid();
#pragma unroll 1
  for (int i = 0; i < 4; ++i) {
    const int c = tid + 256 * i, e = c >> 3, i0 = (c & 7) * 8;
    const u32x4 a = *(const u32x4*)(src + (size_t)e * 512 + i0), b = *(const u32x4*)(src + (size_t)e * 512 + 64 + i0);
    const f32x2* cp = cs + (size_t)(pos0 + e) * 64 + i0;
    const float sc = tokscale(e);
    float x1[8] = {bflo(a.x), bfhi(a.x), bflo(a.y), bfhi(a.y), bflo(a.z), bfhi(a.z), bflo(a.w), bfhi(a.w)};
    float x2[8] = {bflo(b.x), bfhi(b.x), bflo(b.y), bfhi(b.y), bflo(b.z), bfhi(b.z), bflo(b.w), bfhi(b.w)};
    float o1[8], o2[8];
#pragma unroll
    for (int k = 0; k < 8; ++k) { const f32x2 w = cp[k]; o1[k] = (x1[k] * w.x - x2[k] * w.y) * sc; o2[k] = (x1[k] * w.y + x2[k] * w.x) * sc; }
    if (!TRANS) {
      u32x4 w1, w2;
      w1.x = pk2(o1[0], o1[1]); w1.y = pk2(o1[2], o1[3]); w1.z = pk2(o1[4], o1[5]); w1.w = pk2(o1[6], o1[7]);
      w2.x = pk2(o2[0], o2[1]); w2.y = pk2(o2[2], o2[3]); w2.z = pk2(o2[4], o2[5]); w2.w = pk2(o2[6], o2[7]);
      *(u32x4*)(dst + (e * RS + i0) * 2) = w1; *(u32x4*)(dst + (e * RS + 64 + i0) * 2) = w2;
    } else {
#pragma unroll
      for (int k = 0; k < 8; ++k) { *(bf16_t*)(dst + ((i0 + k) * RS + e) * 2) = (bf16_t)f2bf(o1[k]); *(bf16_t*)(dst + ((64 + i0 + k) * RS + e) * 2) = (bf16_t)f2bf(o2[k]); }
    }
  }
}
__device__ __forceinline__ void stage_bf16(unsigned char* dst, const bf16_t* __restrict__ src, size_t ld) {
  const int tid = opaque_tid();
#pragma unroll 4
  for (int i = 0; i < 8; ++i) { const int c = tid + 256 * i, r = c >> 4, kc = c & 15; *(u32x4*)(dst + (r * RS + kc * 8) * 2) = *(const u32x4*)(src + (size_t)r * ld + kc * 8); }
}
__device__ __forceinline__ void stage_f32(unsigned char* dst, const float* __restrict__ src) {
  const int tid = opaque_tid();
#pragma unroll 2
  for (int i = 0; i < 8; ++i) {
    const int c = tid + 256 * i, r = c >> 4, kc = c & 15;
    const f32x4 a = *(const f32x4*)(src + r * 128 + kc * 8), b = *(const f32x4*)(src + r * 128 + kc * 8 + 4);
    u32x4 w; w.x = pk2(a.x, a.y); w.y = pk2(a.z, a.w); w.z = pk2(b.x, b.y); w.w = pk2(b.z, b.w);
    *(u32x4*)(dst + (r * RS + kc * 8) * 2) = w;
  }
}
__device__ __forceinline__ float ret_logg(const Params& p, int dir, int h) {
  const float x = p.in[12][dir * 4 + h];
  return -(x > 20.f ? x : log1pf(expf(x)));
}

__device__ void retU_item(const Params& p, int item, unsigned char* smem) {
  const int gc = item >> 2, h = item & 3, t0 = gc * 128, ts = seq_start(t0), S = seq_len(t0), pos0 = t0 - ts;
  unsigned char* ws = p.ws;
  unsigned char* bufA = smem; unsigned char* bufB = smem + 128 * RS * 2;
  const f32x2* cs = (const f32x2*)(ws + WS_ROPE);
  const bf16_t* Kp = (const bf16_t*)(ws + P_KB) + (size_t)t0 * 512 + h * 128;
  const bf16_t* VT = (const bf16_t*)(ws + P_VTB) + (size_t)ts * 512 + (size_t)(h * 128) * S + pos0;
  const int tid_ = opaque_tid(), lane = tid_ & 63, wid = tid_ >> 6, wr = wid >> 1, wc = wid & 1, fr = lane & 15, fq = lane >> 4;
  stage_bf16(bufA, VT, (size_t)S);
#pragma unroll 1
  for (int dir = 0; dir < 2; ++dir) {
    const float lg = ret_logg(p, dir, h) * 1.4426950408889634f;
    stage_rope<true>(bufB, Kp, pos0, cs, [&](int e) { return 0.08838834764831845f * __builtin_amdgcn_exp2f(lg * (dir == 0 ? (float)(127 - e) : (float)e)); });
    __syncthreads();
    f32x4 acc[4][4];
#pragma unroll
    for (int m = 0; m < 4; ++m)
#pragma unroll
      for (int n = 0; n < 4; ++n) acc[m][n] = (f32x4){0.f, 0.f, 0.f, 0.f};
    lds_gemm128(acc, bufA, bufB);
    float* U = p.out + ((size_t)(gc * 4 + h) * 2 + dir) * 16384;
#pragma unroll
    for (int m = 0; m < 4; ++m)
#pragma unroll
      for (int n = 0; n < 4; ++n) *(f32x4*)(U + (wr * 64 + m * 16 + fr) * 128 + wc * 64 + n * 16 + fq * 4) = acc[m][n];
    __syncthreads();
  }
}

__device__ void ret_scan(const Params& p) {
  const int total = 34 * 4 * 2 * 4096;
  for (int i = blockIdx.x * 256 + threadIdx.x; i < total; i += gridDim.x * 256) {
    const int e4 = i & 4095, sd = i >> 12, dir = sd & 1, h = (sd >> 1) & 3, seq = sd >> 3;
    const int nc = seq < 2 ? 128 : 16, gc0 = seq < 2 ? seq * 128 : 256 + (seq - 2) * 16;
    const float gC = expf(128.0f * ret_logg(p, dir, h));
    f32x4 carry = (f32x4){0.f, 0.f, 0.f, 0.f};
    for (int c = 0; c < nc; ++c) {
      const int cc = dir == 0 ? c : nc - 1 - c;
      f32x4* R = (f32x4*)(p.out + ((size_t)((gc0 + cc) * 4 + h) * 2 + dir) * 16384) + e4;
      const f32x4 u = *R;
      *R = carry;
      carry = carry * gC + u;
    }
  }
}

__device__ void retO_item(const Params& p, int item, unsigned char* smem) {
  const int gc = item >> 2, h = item & 3, t0 = gc * 128, ts = seq_start(t0), S = seq_len(t0), pos0 = t0 - ts;
  unsigned char* ws = p.ws;
  unsigned char* bufA = smem; unsigned char* bufB = smem + 128 * RS * 2;
  const f32x2* cs = (const f32x2*)(ws + WS_ROPE);
  const bf16_t* Qp = (const bf16_t*)(ws + P_QB) + (size_t)t0 * 512 + h * 128;
  const bf16_t* Kp = (const bf16_t*)(ws + P_KB) + (size_t)t0 * 512 + h * 128;
  const bf16_t* VT = (const bf16_t*)(ws + P_VTB) + (size_t)ts * 512 + (size_t)(h * 128) * S + pos0;
  const float* R0 = p.out + ((size_t)(gc * 4 + h) * 2 + 0) * 16384;
  const float* R1 = R0 + 16384;
  const int tid_ = opaque_tid(), lane = tid_ & 63, wid = tid_ >> 6, wr = wid >> 1, wc = wid & 1, fr = lane & 15, fq = lane >> 4;
  const float lg0 = ret_logg(p, 0, h) * 1.4426950408889634f, lg1 = ret_logg(p, 1, h) * 1.4426950408889634f;
  f32x4 acc[4][4];
  bf16_t* pscr = (bf16_t*)(ws + WS_END + (size_t)blockIdx.x * 32768);
#define ZERO44(a_) _Pragma("unroll") for (int m = 0; m < 4; ++m) _Pragma("unroll") for (int n = 0; n < 4; ++n) a_[m][n] = (f32x4){0.f, 0.f, 0.f, 0.f}
  stage_rope<false>(bufA, Qp, pos0, cs, [](int) { return 1.0f; });
  stage_rope<false>(bufB, Kp, pos0, cs, [](int) { return 0.08838834764831845f; });
  __syncthreads();
  ZERO44(acc);
  lds_gemm128(acc, bufA, bufB);
#pragma unroll
  for (int m = 0; m < 4; ++m)
#pragma unroll
    for (int n = 0; n < 4; ++n) {
      const int i = wr * 64 + m * 16 + fr, e0 = wc * 64 + n * 16 + fq * 4;
      float v[4];
#pragma unroll
      for (int r = 0; r < 4; ++r) {
        const int d = i - (e0 + r);
        const float mm = d > 0 ? __builtin_amdgcn_exp2f(lg0 * (float)d) : (d < 0 ? __builtin_amdgcn_exp2f(lg1 * (float)(-d)) : 2.0f);
        v[r] = acc[m][n][r] * mm;
      }
      u32x2 w; w.x = pk2(v[0], v[1]); w.y = pk2(v[2], v[3]);
      *(u32x2*)(pscr + i * 128 + e0) = w;
    }
  fence_sync();
  stage_rope<false>(bufA, Qp, pos0, cs, [&](int e) { return __builtin_amdgcn_exp2f(lg0 * (float)(e + 1)); });
  stage_f32(bufB, R0);
  __syncthreads();
  ZERO44(acc);
  lds_gemm128(acc, bufA, bufB);
  __syncthreads();
  stage_rope<false>(bufA, Qp, pos0, cs, [&](int e) { return __builtin_amdgcn_exp2f(lg1 * (float)(128 - e)); });
  stage_f32(bufB, R1);
  __syncthreads();
  lds_gemm128(acc, bufA, bufB);
  __syncthreads();
  stage_bf16(bufA, pscr, 128);
  stage_bf16(bufB, VT, (size_t)S);
  __syncthreads();
  lds_gemm128(acc, bufA, bufB);
  __syncthreads();
  float* red = (float*)bufB;
#pragma unroll
  for (int m = 0; m < 4; ++m) {
    float ss = 0.f;
#pragma unroll
    for (int n = 0; n < 4; ++n) ss += acc[m][n].x * acc[m][n].x + acc[m][n].y * acc[m][n].y + acc[m][n].z * acc[m][n].z + acc[m][n].w * acc[m][n].w;
    ss += __shfl_xor(ss, 16); ss += __shfl_xor(ss, 32);
    if (fq == 0) red[(wr * 64 + m * 16 + fr) * 2 + wc] = ss;
  }
  __syncthreads();
  const bf16_t* G = (const bf16_t*)(ws + P_GB);
  bf16_t* Y = (bf16_t*)(ws + WS_Y);
#pragma unroll
  for (int m = 0; m < 4; ++m) {
    const int i = wr * 64 + m * 16 + fr;
    const float rstd = 1.0f / sqrtf((red[i * 2] + red[i * 2 + 1]) * (1.0f / 128.0f) + 1e-6f);
#pragma unroll
    for (int n = 0; n < 4; ++n) {
      const int col = h * 128 + wc * 64 + n * 16 + fq * 4;
      const u32x2 gw = *(const u32x2*)(G + (size_t)(t0 + i) * 512 + col);
      const float g[4] = {bflo(gw.x), bfhi(gw.x), bflo(gw.y), bfhi(gw.y)};
      float v[4];
#pragma unroll
      for (int r = 0; r < 4; ++r) v[r] = acc[m][n][r] * rstd * (g[r] / (1.0f + expf(-g[r])));
      u32x2 w; w.x = pk2(v[0], v[1]); w.y = pk2(v[2], v[3]);
      *(u32x2*)(Y + (size_t)(t0 + i) * 1024 + 512 + col) = w;
    }
  }
  __syncthreads();
#undef ZERO44
}

__device__ __forceinline__ float dpp_xor1(float v) { return __builtin_bit_cast(float, __builtin_amdgcn_update_dpp(0, __builtin_bit_cast(int, v), 0xB1, 0xF, 0xF, true)); }
__device__ __forceinline__ float dpp_xor2(float v) { return __builtin_bit_cast(float, __builtin_amdgcn_update_dpp(0, __builtin_bit_cast(int, v), 0x4E, 0xF, 0xF, true)); }

__device__ __forceinline__ float dpp_hmirror(float v) { return __builtin_bit_cast(float, __builtin_amdgcn_update_dpp(0, __builtin_bit_cast(int, v), 0x141, 0xF, 0xF, true)); }
__device__ __forceinline__ float dpp_mirror(float v) { return __builtin_bit_cast(float, __builtin_amdgcn_update_dpp(0, __builtin_bit_cast(int, v), 0x140, 0xF, 0xF, true)); }
__device__ __forceinline__ float red16(float v) { v += dpp_xor1(v); v += dpp_xor2(v); v += dpp_hmirror(v); v += dpp_mirror(v); return v; }
__device__ __forceinline__ float wave_sum_fast(float v) { v = red16(v); v += __shfl_xor(v, 16); v += __shfl_xor(v, 32); return v; }
__device__ __forceinline__ float red8(float v) { v += dpp_xor1(v); v += dpp_xor2(v); v += dpp_hmirror(v); return v; }

template <bool DUAL>
__device__ __forceinline__ void rwkv_chain(const Params& p, int z, int seq, int h, int ci_beg, int ci_end, int mode, const float* st_in, float* st_out, float* st_out2, unsigned char* smem) {
  const int S = seq < 2 ? 16384 : 2048, ts = seq < 2 ? seq * 16384 : TP + (seq - 2) * 2048;
  unsigned char* ws = p.ws;
  const bf16_t* PC = (const bf16_t*)(ws + P_PC) + (size_t)ts * 1792;
  bf16_t* YS = (bf16_t*)(ws + WS_YS) + (size_t)z * T * 512 + (size_t)ts * 512 + h * 64;
  const bf16_t* w2T = (const bf16_t*)(ws + W_W2) + (size_t)(z * 512 + h * 64) * 64;
  const bf16_t* a2T = (const bf16_t*)(ws + W_A2) + (size_t)(z * 512 + h * 64) * 64;
  float* sR = (float*)smem;
  float* sKP = sR + 1024;
  float* sKA = sKP + 1024;
  float* sV = sKA + 1024;
  float* sW = sV + 1024;
  float* sKB = sW + 1024;
  float* sKM = sKB + 1024;
  float* sYO = sKM + 1024;
  float* sBon = sYO + 1024;
  unsigned char* sTW = (unsigned char*)(sBon + 64);
  unsigned char* sTA = sTW + 16 * 144;
  float* sYP = (float*)(sTA + 16 * 144);
  float* sV2 = sYP + 16 * 64 * 8;
  const int tid = opaque_tid(), lane = tid & 63, wid = tid >> 6, fr = lane & 15, fq = lane >> 4;
  const int j = lane;
  const int cg5[5] = {h * 64 + j, 512 + h * 64 + j, 1024 + h * 64 + j, 1536 + j, 1600 + j};
  float mu0[5], mu1[5];
#pragma unroll
  for (int g = 0; g < 5; ++g) { mu0[g] = p.in[15][cg5[g]]; mu1[g] = p.in[15][1792 + cg5[g]]; }
  const float kkw = p.in[21][h * 64 + j];
  const int cj = h * 64 + wid * 16 + fr;
  const float c_ka = p.in[22][cj], c_rk = p.in[23][cj], c_w0 = p.in[16][z * 512 + cj], c_a0 = p.in[18][z * 512 + cj];
  bf16x8 bw[2], ba[2];
#pragma unroll
  for (int ks = 0; ks < 2; ++ks) { bw[ks] = *(const bf16x8*)(w2T + (size_t)(wid * 16 + fr) * 64 + ks * 32 + fq * 8); ba[ks] = *(const bf16x8*)(a2T + (size_t)(wid * 16 + fr) * 64 + ks * 32 + fq * 8); }
  const int q8 = lane & 7, row0 = wid * 16 + 2 * (lane >> 3);
  f32x2 st[2][4];
#pragma unroll
  for (int r = 0; r < 2; ++r)
#pragma unroll
    for (int c = 0; c < 4; ++c) {
      if (mode == 3) st[r][c] = *(const f32x2*)(st_in + (row0 + r) * 64 + q8 * 8 + 2 * c);
      else if (mode == 2) st[r][c] = (f32x2){(row0 + r) == (q8 * 8 + 2 * c) ? 1.f : 0.f, (row0 + r) == (q8 * 8 + 2 * c + 1) ? 1.f : 0.f};
      else st[r][c] = (f32x2){0.f, 0.f};
    }
  f32x2 sp[2][4];
#pragma unroll
  for (int r = 0; r < 2; ++r)
#pragma unroll
    for (int c = 0; c < 4; ++c) sp[r][c] = (f32x2){(row0 + r) == (q8 * 8 + 2 * c) ? 1.f : 0.f, (row0 + r) == (q8 * 8 + 2 * c + 1) ? 1.f : 0.f};
  const float vmul = mode == 2 ? 0.f : 1.f;
  const bool wout = (mode == 0 || mode == 3);
  u32x2 pend_w = (u32x2){0u, 0u}; long pend_off = -1;
  unsigned short raw[5][6];
#define RWKV_LOAD(ci_) do { const int p0_ = z == 0 ? (ci_) * 16 : S - 16 - (ci_) * 16; \
    _Pragma("unroll") for (int k = 0; k < 6; ++k) { int pos_ = z == 0 ? p0_ + 4 * wid - 1 + k : p0_ + 16 - 4 * wid - k; pos_ = pos_ < 0 ? 0 : (pos_ > S - 1 ? S - 1 : pos_); \
      _Pragma("unroll") for (int g = 0; g < 5; ++g) raw[g][k] = PC[(size_t)pos_ * 1792 + cg5[g]]; } } while (0)
  RWKV_LOAD(ci_beg);
#pragma unroll 1
  for (int ci = ci_beg; ci < ci_end; ++ci) {
    const int p0 = z == 0 ? ci * 16 : S - 16 - ci * 16;
    float* sVc = (ci & 1) ? sV2 : sV;
#pragma unroll
    for (int u = 0; u < 4; ++u) {
      const int s = wid * 4 + u, pos = z == 0 ? p0 + s : p0 + 15 - s;
      float x[5];
#pragma unroll
      for (int g = 0; g < 5; ++g) {
        const float xc = bf2f(raw[g][1 + u]);
        const float xa = bf2f(raw[g][u]), xb = bf2f(raw[g][2 + u]);
        const float xp = pos > 0 ? (z == 0 ? xa : xb) : 0.f;
        const float xn = pos < S - 1 ? (z == 0 ? xb : xa) : 0.f;
        x[g] = xc + mu0[g] * (xp - xc) + mu1[g] * (xn - xc);
      }
      sR[s * 64 + j] = x[0]; sKP[s * 64 + j] = x[1]; sVc[s * 64 + j] = x[2];
      const float kr = x[1] * kkw;
      const float nn = wave_sum_fast(kr * kr);
      sKA[s * 64 + j] = -kr * __builtin_amdgcn_rsqf(fmaxf(nn, 1e-24f));
      const float xz = fminf(fmaxf(x[3], -15.f), 15.f);
      const float e2 = __expf(2.0f * xz);
      *(bf16_t*)(sTW + (s * 72 + j) * 2) = (bf16_t)f2bf((e2 - 1.0f) * __builtin_amdgcn_rcpf(e2 + 1.0f));
      *(bf16_t*)(sTA + (s * 72 + j) * 2) = (bf16_t)f2bf(x[4]);
    }
    __syncthreads();
    {
      f32x4 dw = (f32x4){0.f, 0.f, 0.f, 0.f}, da = dw;
#pragma unroll
      for (int ks = 0; ks < 2; ++ks) {
        const bf16x8 aw = *(const bf16x8*)(sTW + (fr * 72 + ks * 32 + fq * 8) * 2);
        const bf16x8 aa = *(const bf16x8*)(sTA + (fr * 72 + ks * 32 + fq * 8) * 2);
        dw = mfma16(aw, bw[ks], dw); da = mfma16(aa, ba[ks], da);
      }
      const int col = wid * 16 + fr;
#pragma unroll
      for (int r = 0; r < 4; ++r) {
        const int s = 4 * fq + r;
        const float wl = c_w0 + dw[r];
        const float w = __expf(-0.6065306597126334f * __builtin_amdgcn_rcpf(1.0f + __expf(-wl)));
        const float a = __builtin_amdgcn_rcpf(1.0f + __expf(-(c_a0 + da[r])));
        const float kp = sKP[s * 64 + col], kk = -sKA[s * 64 + col], rr = sR[s * 64 + col];
        const float km = kp * (1.0f + (a - 1.0f) * c_ka);
        sW[s * 64 + col] = w; sKB[s * 64 + col] = kk * a; sKM[s * 64 + col] = km;
        const float bp = red16(rr * km * c_rk);
        if (fr == 0) sBon[wid * 16 + s] = bp;
      }
    }
    __syncthreads();
    if (pend_off >= 0) *(u32x2*)(YS + pend_off) = pend_w;
    if (ci + 1 < ci_end) RWKV_LOAD(ci + 1);
    f32x4 opn[10]; f32x2 vvn; float bonn;
#define RWKV_OPLOAD(s_) do { const int s__ = (s_); \
      opn[0] = *(const f32x4*)(sW + s__ * 64 + q8 * 8); opn[1] = *(const f32x4*)(sW + s__ * 64 + q8 * 8 + 4); \
      opn[2] = *(const f32x4*)(sKA + s__ * 64 + q8 * 8); opn[3] = *(const f32x4*)(sKA + s__ * 64 + q8 * 8 + 4); \
      opn[4] = *(const f32x4*)(sKB + s__ * 64 + q8 * 8); opn[5] = *(const f32x4*)(sKB + s__ * 64 + q8 * 8 + 4); \
      opn[6] = *(const f32x4*)(sKM + s__ * 64 + q8 * 8); opn[7] = *(const f32x4*)(sKM + s__ * 64 + q8 * 8 + 4); \
      opn[8] = *(const f32x4*)(sR + s__ * 64 + q8 * 8); opn[9] = *(const f32x4*)(sR + s__ * 64 + q8 * 8 + 4); \
      vvn = *(const f32x2*)(sVc + s__ * 64 + row0); bonn = (sBon[s__] + sBon[16 + s__]) + (sBon[32 + s__] + sBon[48 + s__]); } while (0)
    RWKV_OPLOAD(0);
#pragma unroll 2
    for (int s = 0; s < 16; ++s) {
      const f32x4 w0 = opn[0], w1 = opn[1], a0 = opn[2], a1 = opn[3], b0 = opn[4], b1 = opn[5], m0 = opn[6], m1 = opn[7], r0 = opn[8], r1 = opn[9];
      const f32x2 vv = vvn * vmul; const float bon = bonn;
      if (s < 15) RWKV_OPLOAD(s + 1);
      const f32x2 W2[4] = {(f32x2){w0.x, w0.y}, (f32x2){w0.z, w0.w}, (f32x2){w1.x, w1.y}, (f32x2){w1.z, w1.w}};
      const f32x2 A2[4] = {(f32x2){a0.x, a0.y}, (f32x2){a0.z, a0.w}, (f32x2){a1.x, a1.y}, (f32x2){a1.z, a1.w}};
      const f32x2 B2[4] = {(f32x2){b0.x, b0.y}, (f32x2){b0.z, b0.w}, (f32x2){b1.x, b1.y}, (f32x2){b1.z, b1.w}};
      const f32x2 M2[4] = {(f32x2){m0.x, m0.y}, (f32x2){m0.z, m0.w}, (f32x2){m1.x, m1.y}, (f32x2){m1.z, m1.w}};
      const f32x2 R2[4] = {(f32x2){r0.x, r0.y}, (f32x2){r0.z, r0.w}, (f32x2){r1.x, r1.y}, (f32x2){r1.z, r1.w}};
      if constexpr (DUAL) {
#pragma unroll
        for (int r = 0; r < 2; ++r) {
          const float vi = r == 0 ? vv.x : vv.y;
          f32x2 sacc = st[r][0] * A2[0], pacc = sp[r][0] * A2[0];
#pragma unroll
          for (int c = 1; c < 4; ++c) { sacc = st[r][c] * A2[c] + sacc; pacc = sp[r][c] * A2[c] + pacc; }
          const float sa = red8(sacc.x + sacc.y), pa = red8(pacc.x + pacc.y);
          const f32x2 sa2 = (f32x2){sa, sa}, vi2 = (f32x2){vi, vi}, pa2 = (f32x2){pa, pa};
#pragma unroll
          for (int c = 0; c < 4; ++c) {
            st[r][c] = st[r][c] * W2[c] + (sa2 * B2[c] + vi2 * M2[c]);
            sp[r][c] = sp[r][c] * W2[c] + pa2 * B2[c];
          }
        }
      } else {
      float yy[2];
#pragma unroll
      for (int r = 0; r < 2; ++r) {
        const float vi = r == 0 ? vv.x : vv.y;
        f32x2 sacc = st[r][0] * A2[0];
#pragma unroll
        for (int c = 1; c < 4; ++c) sacc = st[r][c] * A2[c] + sacc;
        const float sa = red8(sacc.x + sacc.y);
        const f32x2 sa2 = (f32x2){sa, sa}, vi2 = (f32x2){vi, vi};
        f32x2 yacc = (f32x2){0.f, 0.f};
#pragma unroll
        for (int c = 0; c < 4; ++c) {
          st[r][c] = st[r][c] * W2[c] + (sa2 * B2[c] + vi2 * M2[c]);
          yacc = st[r][c] * R2[c] + yacc;
        }
        yy[r] = yacc.x + yacc.y;
      }
      sYP[(s * 64 + row0) * 8 + q8] = yy[0]; sYP[(s * 64 + row0 + 1) * 8 + q8] = yy[1];
      }
    }
#undef RWKV_OPLOAD
    __syncthreads();
    if (wout) {
      const int s = tid >> 4, c4 = (tid & 15) * 4, pos = z == 0 ? p0 + s : p0 + 15 - s;
      const float bon = (sBon[s] + sBon[16 + s]) + (sBon[32 + s] + sBon[48 + s]);
      const f32x4 vv4 = *(const f32x4*)(sVc + s * 64 + c4);
      float yo[4];
#pragma unroll
      for (int r = 0; r < 4; ++r) {
        const f32x4 a = *(const f32x4*)(sYP + (s * 64 + c4 + r) * 8), b = *(const f32x4*)(sYP + (s * 64 + c4 + r) * 8 + 4);
        yo[r] = ((a.x + a.y) + (a.z + a.w)) + ((b.x + b.y) + (b.z + b.w)) + bon * vv4[r];
      }
      pend_w.x = pk2(yo[0], yo[1]); pend_w.y = pk2(yo[2], yo[3]);
      pend_off = (long)pos * 512 + c4;
    }
  }
  if (pend_off >= 0) *(u32x2*)(YS + pend_off) = pend_w;
  if (mode == 1 || mode == 2) {
#pragma unroll
    for (int r = 0; r < 2; ++r) {
      *(f32x4*)(st_out + (row0 + r) * 64 + q8 * 8) = (f32x4){st[r][0].x, st[r][0].y, st[r][1].x, st[r][1].y};
      *(f32x4*)(st_out + (row0 + r) * 64 + q8 * 8 + 4) = (f32x4){st[r][2].x, st[r][2].y, st[r][3].x, st[r][3].y};
      if constexpr (DUAL) {
        *(f32x4*)(st_out2 + (row0 + r) * 64 + q8 * 8) = (f32x4){sp[r][0].x, sp[r][0].y, sp[r][1].x, sp[r][1].y};
        *(f32x4*)(st_out2 + (row0 + r) * 64 + q8 * 8 + 4) = (f32x4){sp[r][2].x, sp[r][2].y, sp[r][3].x, sp[r][3].y};
      }
    }
  }
#undef RWKV_LOAD
  __syncthreads();
}

constexpr size_t WS_RL = WS_END + 16 * MiB, WS_RPHI = WS_RL + 8 * MiB, WS_RS = WS_RPHI + 8 * MiB;
__device__ void rwkv_combine(const Params& p, int ch, unsigned char* smem) {
  float* sS = (float*)smem;
  const int tid = opaque_tid(), jcol = tid & 63, ig = tid >> 6;
  const float* L = (const float*)(p.ws + WS_RL) + (size_t)ch * 16 * 4096;
  const float* PH = (const float*)(p.ws + WS_RPHI) + (size_t)ch * 16 * 4096;
  float* SO = (float*)(p.ws + WS_RS) + (size_t)ch * 16 * 4096;
  float cur[16];
#pragma unroll
  for (int r = 0; r < 16; ++r) cur[r] = 0.f;
#pragma unroll 1
  for (int k = 0; k < 16; ++k) {
#pragma unroll
    for (int r = 0; r < 16; ++r) { SO[(size_t)k * 4096 + (ig * 16 + r) * 64 + jcol] = cur[r]; sS[(ig * 16 + r) * 65 + jcol] = cur[r]; }
    __syncthreads();
    if (k < 15) {
      float acc[16];
#pragma unroll
      for (int r = 0; r < 16; ++r) acc[r] = L[(size_t)k * 4096 + (ig * 16 + r) * 64 + jcol];
#pragma unroll 4
      for (int m = 0; m < 64; ++m) {
        const float ph = PH[(size_t)k * 4096 + m * 64 + jcol];
#pragma unroll
        for (int r = 0; r < 16; ++r) acc[r] += sS[(ig * 16 + r) * 65 + m] * ph;
      }
#pragma unroll
      for (int r = 0; r < 16; ++r) cur[r] = acc[r];
    }
    __syncthreads();
  }
}

__device__ __forceinline__ int next_item(unsigned* ctr, unsigned char* smem) {
  volatile int* slot = (volatile int*)(smem + SMEM_BYTES - 16);
  __syncthreads();
  if (threadIdx.x == 0) *slot = (int)atomicAdd(ctr, 1u);
  __syncthreads();
  return *slot;
}

__device__ void phase1(const Params& p, unsigned char* smem) {
  unsigned char* ws = p.ws;
  bf16_t* H = (bf16_t*)(ws + WS_Y);
  const bf16_t* W = (const bf16_t*)(ws + W_INE);
  for (int sp = blockIdx.x; sp < NSTRIPE / 2; sp += gridDim.x) {
    const int t0 = sp * 192;
    norm_stripe<0>(p, t0, p.in[3], H); norm_stripe<0>(p, t0 + 96, p.in[3], H);
    fence_sync();
    gemm192(H + (size_t)t0 * DM, DM, W, DM, 0, 0, DM, 14, smem, [&](int nt, int r, int c, f32x4 v) {
      const int t = t0 + r, arr = nt >> 1, cb = (nt & 1) * 256 + c;
      bf16_t* dst = (bf16_t*)(ws + WS_P + (size_t)arr * PE_SZ);
      if (!(arr == 2 || arr == 5)) { u32x2 w; w.x = pk2(v.x, v.y); w.y = pk2(v.z, v.w); __builtin_nontemporal_store(w, (u32x2*)(dst + (size_t)t * 512 + cb)); }
      else {
        const int ts = seq_start(t), S = seq_len(t), pos = t - ts;
        bf16_t* d = dst + (size_t)ts * 512 + (size_t)cb * S + pos;
        d[0] = (bf16_t)f2bf(v.x); d[S] = (bf16_t)f2bf(v.y); d[2 * (size_t)S] = (bf16_t)f2bf(v.z); d[3 * (size_t)S] = (bf16_t)f2bf(v.w);
      }
    });
    fence_sync();
  }
}

template <int LAYER, int NQ>
__device__ __forceinline__ void ffn_stripe(const Params& p, int t0, unsigned char* smem, bf16_t* H, bf16_t* hid) {
  constexpr int HC = 4096 / NQ;
  unsigned char* ws = p.ws;
  const bf16_t* Wup = (const bf16_t*)(ws + W_UP0 + (size_t)LAYER * 8 * MiB);
  const bf16_t* Wdn = (const bf16_t*)(ws + W_DN0 + (size_t)LAYER * 8 * MiB);
#pragma unroll 1
  for (int q = 0; q < NQ; ++q) {
    gemm192(H + (size_t)t0 * DM, DM, Wup, DM, q * HC, 0, DM, HC / 256, smem, [&](int nt, int r, int c, f32x4 v) {
      v.x = v.x > 0.f ? v.x * v.x : 0.f; v.y = v.y > 0.f ? v.y * v.y : 0.f; v.z = v.z > 0.f ? v.z * v.z : 0.f; v.w = v.w > 0.f ? v.w * v.w : 0.f;
      u32x2 w; w.x = pk2(v.x, v.y); w.y = pk2(v.z, v.w);
      *(u32x2*)(hid + (size_t)r * HC + nt * 256 + c) = w;
    });
    fence_sync();
    gemm192(hid, HC, Wdn, DFF, 0, q * HC, HC, 4, smem, [&](int nt, int r, int c, f32x4 v) {
      float* d = p.out + (size_t)(t0 + r) * DM + nt * 256 + c;
      *(f32x4*)d = *(const f32x4*)d + v;
    });
    fence_sync();
  }
}

__device__ void phase5(const Params& p, unsigned char* smem) {
  unsigned char* ws = p.ws;
  bf16_t* Y = (bf16_t*)(ws + WS_Y);
  bf16_t* hid = (bf16_t*)(ws + WS_YS + (size_t)blockIdx.x * HID_BLK);
  const bf16_t* Wo = (const bf16_t*)(ws + W_OUTE);
  const bf16_t* Wi = (const bf16_t*)(ws + W_INO);
  for (int sp = blockIdx.x; sp < NSTRIPE / 2; sp += gridDim.x) {
    const int t0 = sp * 192;
    gemm192(Y + (size_t)t0 * DM, DM, Wo, DM, 0, 0, DM, 4, smem, [&](int nt, int r, int c, f32x4 v) {
      const int t = t0 + r;
      const f32x4 xi = *(const f32x4*)(xin_row(p, t) + nt * 256 + c);
      *(f32x4*)(p.out + (size_t)t * DM + nt * 256 + c) = xi + v;
    });
    fence_sync();
    norm_stripe<1>(p, t0, p.in[4], Y); norm_stripe<1>(p, t0 + 96, p.in[4], Y);
    fence_sync();
    ffn_stripe<0, 4>(p, t0, smem, Y, hid);
    norm_stripe<1>(p, t0, p.in[3] + DM, Y); norm_stripe<1>(p, t0 + 96, p.in[3] + DM, Y);
    fence_sync();
    gemm192(Y + (size_t)t0 * DM, DM, Wi, DM, 0, 0, DM, 10, smem, [&](int nt, int r, int c, f32x4 v) {
      const int t = t0 + r, gcol = nt * 256 + c;
      u32x2 w; w.x = pk2(v.x, v.y); w.y = pk2(v.z, v.w);
      if (gcol < 1792) __builtin_nontemporal_store(w, (u32x2*)((bf16_t*)(ws + P_PC) + (size_t)t * 1792 + gcol));
      else if (gcol < 2304) __builtin_nontemporal_store(w, (u32x2*)((bf16_t*)(ws + P_QD) + (size_t)t * 512 + (gcol - 1792)));
      else if (gcol < 2432) __builtin_nontemporal_store(w, (u32x2*)((bf16_t*)(ws + P_KD) + (size_t)t * 128 + (gcol - 2304)));
      else {
        const int ts = seq_start(t), S = seq_len(t), pos = t - ts;
        bf16_t* d = (bf16_t*)(ws + P_VTD) + (size_t)ts * 128 + (size_t)(gcol - 2432) * S + pos;
        d[0] = (bf16_t)f2bf(v.x); d[S] = (bf16_t)f2bf(v.y); d[2 * (size_t)S] = (bf16_t)f2bf(v.z); d[3 * (size_t)S] = (bf16_t)f2bf(v.w);
      }
    });
    fence_sync();
  }
}

__device__ void phase7(const Params& p, unsigned char* smem) {
  unsigned char* ws = p.ws;
  bf16_t* Y = (bf16_t*)(ws + WS_Y);
  const bf16_t* PC = (const bf16_t*)(ws + P_PC);
  const bf16_t* YS0 = (const bf16_t*)(ws + WS_YS);
  const bf16_t* YS1 = YS0 + (size_t)T * 512;
  bf16_t* zs = (bf16_t*)(ws + WS_ZG + (size_t)blockIdx.x * (96 * 128 * 2));
  const bf16_t* G2 = (const bf16_t*)(ws + W_G2);
  const bf16_t* Wo = (const bf16_t*)(ws + W_OUTO);
  float* stats = (float*)(smem + 73728);
  for (int sp2 = blockIdx.x; sp2 < NSTRIPE / 2; sp2 += gridDim.x) {
   const int t00 = sp2 * 192;
#pragma unroll 1
   for (int hf = 0; hf < 2; ++hf) {
    const int t0 = t00 + hf * 96;
    const int tid = opaque_tid(), lane = tid & 63, wid = tid >> 6;
    __syncthreads();
    for (int i = tid; i < 96 * 128; i += 256) {
      const int r = i >> 7, c = i & 127, t = t0 + r, ts = seq_start(t), S = seq_len(t), pos = t - ts, col = 1664 + c;
      const float xc = bf2f(PC[(size_t)t * 1792 + col]);
      const float xp = pos > 0 ? bf2f(PC[(size_t)(t - 1) * 1792 + col]) : 0.f;
      const float xn = pos < S - 1 ? bf2f(PC[(size_t)(t + 1) * 1792 + col]) : 0.f;
      const float x = xc + p.in[15][col] * (xp - xc) + p.in[15][1792 + col] * (xn - xc);
      zs[i] = (bf16_t)f2bf(1.0f / (1.0f + expf(-x)));
    }
    fence_sync();
#pragma unroll 1
    for (int nt = 0; nt < 2; ++nt) {
      __syncthreads();
      for (int i = wid; i < 96 * 4; i += 4) {
        const int r = i >> 2, hh = nt * 4 + (i & 3);
        const size_t off = (size_t)(t0 + r) * 512 + hh * 64 + lane;
        const float yv = bf2f(YS0[off]) + bf2f(YS1[off]);
        const float mean = wave_sum(yv) * (1.0f / 64.0f);
        const float d = yv - mean;
        const float var = wave_sum(d * d) * (1.0f / 64.0f);
        if (lane == 0) { stats[i * 2] = mean; stats[i * 2 + 1] = 1.0f / sqrtf(var + 64e-5f); }
      }
      __syncthreads();
      gemm_tile(zs, 128, G2 + (size_t)nt * 256 * 128, 128, 128, smem, [&](int r, int c, f32x4 v) {
        const int t = t0 + r, col = nt * 256 + c, hl = c >> 6;
        const float mean = stats[(r * 4 + hl) * 2], rstd = stats[(r * 4 + hl) * 2 + 1];
        const u32x2 a = *(const u32x2*)(YS0 + (size_t)t * 512 + col), b = *(const u32x2*)(YS1 + (size_t)t * 512 + col);
        const f32x4 yv = (f32x4){bflo(a.x) + bflo(b.x), bfhi(a.x) + bfhi(b.x), bflo(a.y) + bflo(b.y), bfhi(a.y) + bfhi(b.y)};
        const f32x4 lw = *(const f32x4*)(p.in[24] + col), lb = *(const f32x4*)(p.in[25] + col);
        const f32x4 o = ((yv - mean) * rstd * lw + lb) * v;
        u32x2 w; w.x = pk2(o.x, o.y); w.y = pk2(o.z, o.w);
        *(u32x2*)(Y + (size_t)t * DM + col) = w;
      });
    }
   }
    fence_sync();
    gemm192(Y + (size_t)t00 * DM, DM, Wo, DM, 0, 0, DM, 4, smem, [&](int nt, int r, int c, f32x4 v) {
      float* d = p.out + (size_t)(t00 + r) * DM + nt * 256 + c;
      *(f32x4*)d = *(const f32x4*)d + v;
    });
    fence_sync();
    norm_stripe<1>(p, t00, p.in[4] + DM, Y); norm_stripe<1>(p, t00 + 96, p.in[4] + DM, Y);
    fence_sync();
  }
}

__device__ void phase8(const Params& p, unsigned char* smem) {
  unsigned char* ws = p.ws;
  bf16_t* Y = (bf16_t*)(ws + WS_Y);
  bf16_t* hid = (bf16_t*)(ws + WS_P + (size_t)blockIdx.x * (2 * HID_BLK));
  for (int sp = blockIdx.x; sp < NSTRIPE / 2; sp += gridDim.x) {
    const int t0 = sp * 192;
    ffn_stripe<1, 2>(p, t0, smem, Y, hid);
    norm_stripe<2>(p, t0, p.in[5], nullptr); norm_stripe<2>(p, t0 + 96, p.in[5], nullptr);
    fence_sync();
  }
}

#ifndef PHMASK
#define PHMASK 0x1ff
#endif
#define PH_ON(k) (((PHMASK) >> (k)) & 1)
#ifndef REPEAT_PH
#define REPEAT_PH -1
#endif
__global__ void __launch_bounds__(256, 2) mega(Params p) {
  __shared__ __attribute__((aligned(16))) unsigned char smem[SMEM_BYTES];
  cg::grid_group grid = cg::this_grid();
  unsigned* ctr = (unsigned*)(p.ws + WS_CTL);
  const int lo = p.ph_lo, hi = p.ph_hi;
#define IN(k) (PH_ON(k) && lo <= (k) && (k) < hi)
#define SEAM(k) do { if (lo <= (k) && (k) + 1 < hi) grid.sync(); } while (0)
  if (IN(0)) phase0(p, smem);
#if REPEAT_PH == 0
  grid.sync(); phase0(p, smem);
#endif
  SEAM(0);
  if (IN(1)) phase1(p, smem);
#if REPEAT_PH == 1
  grid.sync(); phase1(p, smem);
#endif
  SEAM(1);
  if (IN(2)) {
    for (;;) {
      const int it = next_item(ctr + 0, smem);
      if (it >= 2048 + 3072 + 4096) break;
      if (it >= 2048 && it < 2048 + 3072) retU_item(p, it - 2048, smem);
      else diff_item(p, it < 2048 ? it : it - 3072, smem);
    }
  }
#if REPEAT_PH == 2
  grid.sync();
  for (;;) {
    const int it = next_item(ctr + 128, smem);
    if (it >= 2048 + 3072 + 4096) break;
    if (it >= 2048 && it < 2048 + 3072) retU_item(p, it - 2048, smem);
    else diff_item(p, it < 2048 ? it : it - 3072, smem);
  }
#endif
  SEAM(2);
  if (IN(3)) ret_scan(p);
  SEAM(3);
  if (IN(4)) for (int it = blockIdx.x; it < 3072; it += gridDim.x) retO_item(p, it, smem);
#if REPEAT_PH == 4
  grid.sync(); for (int it = blockIdx.x; it < 3072; it += gridDim.x) retO_item(p, it, smem);
#endif
  SEAM(4);
  if (IN(5)) phase5(p, smem);
  SEAM(5);
  if (IN(6)) {
    for (;;) {
      const int it = next_item(ctr + 64, smem);
      if (it >= 512 + 512 + 3072) break;
      if (it < 512) rwkv_chain<false>(p, it & 1, 2 + (it >> 4), (it >> 1) & 7, 0, 128, 0, nullptr, nullptr, nullptr, smem);
      else if (it < 1024) {
        const int i3 = it - 512, z = i3 & 1, h = (i3 >> 1) & 7, sg = (i3 >> 4) & 15, seq = i3 >> 8, ch = (seq * 8 + h) * 2 + z;
        float* dL = (float*)(p.ws + WS_RL) + ((size_t)ch * 16 + sg) * 4096;
        float* dP = (float*)(p.ws + WS_RPHI) + ((size_t)ch * 16 + sg) * 4096;
        rwkv_chain<true>(p, z, seq, h, sg * 64, sg * 64 + 64, 1, nullptr, dL, dP, smem);
      } else swa_item(p, it - 1024, smem);
    }
    grid.sync();
    if (blockIdx.x < 32) rwkv_combine(p, blockIdx.x, smem);
    grid.sync();
    for (int it = blockIdx.x; it < 512; it += gridDim.x) {
      const int z = it & 1, h = (it >> 1) & 7, sg = (it >> 4) & 15, seq = it >> 8, ch = (seq * 8 + h) * 2 + z;
      rwkv_chain<false>(p, z, seq, h, sg * 64, sg * 64 + 64, 3, (const float*)(p.ws + WS_RS) + ((size_t)ch * 16 + sg) * 4096, nullptr, nullptr, smem);
    }
  }
#if REPEAT_PH == 6
  grid.sync();
  {
    for (;;) {
      const int it = next_item(ctr + 192, smem);
      if (it >= 512 + 512 + 3072) break;
      if (it < 512) rwkv_chain<false>(p, it & 1, 2 + (it >> 4), (it >> 1) & 7, 0, 128, 0, nullptr, nullptr, nullptr, smem);
      else if (it < 1024) {
        const int i3 = it - 512, z = i3 & 1, h = (i3 >> 1) & 7, sg = (i3 >> 4) & 15, seq = i3 >> 8, ch = (seq * 8 + h) * 2 + z;
        float* dL = (float*)(p.ws + WS_RL) + ((size_t)ch * 16 + sg) * 4096;
        float* dP = (float*)(p.ws + WS_RPHI) + ((size_t)ch * 16 + sg) * 4096;
        rwkv_chain<true>(p, z, seq, h, sg * 64, sg * 64 + 64, 1, nullptr, dL, dP, smem);
      } else swa_item(p, it - 1024, smem);
    }
    grid.sync();
    if (blockIdx.x < 32) rwkv_combine(p, blockIdx.x, smem);
    grid.sync();
    for (int it = blockIdx.x; it < 512; it += gridDim.x) {
      const int z = it & 1, h = (it >> 1) & 7, sg = (it >> 4) & 15, seq = it >> 8, ch = (seq * 8 + h) * 2 + z;
      rwkv_chain<false>(p, z, seq, h, sg * 64, sg * 64 + 64, 3, (const float*)(p.ws + WS_RS) + ((size_t)ch * 16 + sg) * 4096, nullptr, nullptr, smem);
    }
  }
#endif
  SEAM(6);
  if (IN(7)) phase7(p, smem);
  SEAM(7);
  if (IN(8)) phase8(p, smem);
#undef IN
#undef SEAM
}

extern "C" void kernel_launch(void* const* d_in, const int* in_sizes, int n_in, void* d_out, int out_size, void* d_ws, size_t ws_size, hipStream_t stream) {
  static int grid_blocks = 0;
  if (!grid_blocks) {
    if (n_in != 27 || out_size != T * DM || ws_size < WS_END + 40 * MiB) { fprintf(stderr, "kernel_launch: unexpected shapes (n_in %d out %d ws %zu)\n", n_in, out_size, ws_size); grid_blocks = -1; return; }
    int dev = 0, cus = 0, per_cu = 0;
    hipGetDevice(&dev);
    hipDeviceGetAttribute(&cus, hipDeviceAttributeMultiprocessorCount, dev);
    hipOccupancyMaxActiveBlocksPerMultiprocessor(&per_cu, mega, 256, 0);
    if (per_cu < 1) per_cu = 1;
    if (per_cu > 2) per_cu = 2;
    grid_blocks = cus * per_cu;
    if (grid_blocks > MAXGRID) grid_blocks = MAXGRID;
  }
  if (grid_blocks < 0) return;
  hipMemsetAsync((char*)d_ws + WS_CTL, 0, 4096, stream);
  Params p{};
  for (int i = 0; i < 27; ++i) p.in[i] = (const float*)d_in[i];
  p.out = (float*)d_out; p.ws = (unsigned char*)d_ws;
#define ONE_LAUNCH 1
#if !ONE_LAUNCH
#ifndef MAXPH
#define MAXPH 9
#endif
  for (int ph = 0; ph < MAXPH; ++ph) {
    p.ph_lo = ph; p.ph_hi = ph + 1;
    void* args[] = {&p};
    hipError_t e = hipLaunchCooperativeKernel((void*)mega, dim3(grid_blocks), dim3(256), args, 0, stream);
    if (e != hipSuccess) { fprintf(stderr, "launch %d failed: %s\n", ph, hipGetErrorString(e)); break; }
  }
#else
  p.ph_lo = 0; p.ph_hi = 9;
  void* args[] = {&p};
  hipError_t e = hipLaunchCooperativeKernel((void*)mega, dim3(grid_blocks), dim3(256), args, 0, stream);
  if (e != hipSuccess) fprintf(stderr, "cooperative launch failed: %s (grid %d)\n", hipGetErrorString(e), grid_blocks);
#endif
}
```

```cpp
#include <hip/hip_runtime.h>
#include <hip/hip_cooperative_groups.h>
#include <cstdio>
#include <cstdint>
namespace cg = cooperative_groups;

typedef unsigned short bf16_t;
typedef short bf16x8 __attribute__((ext_vector_type(8)));
typedef float f32x4 __attribute__((ext_vector_type(4)));
typedef float f32x2 __attribute__((ext_vector_type(2)));
typedef unsigned u32x4 __attribute__((ext_vector_type(4)));
typedef unsigned u32x2 __attribute__((ext_vector_type(2)));

constexpr int T = 98304, TP = 32768, DM = 1024, DFF = 4096;
constexpr int NSTRIPE = T / 96;
constexpr int NGC = T / 128;
constexpr size_t MiB = 1u << 20;
constexpr size_t WS_CTL = 0;
constexpr size_t WS_TAB = 64 * 1024;
constexpr size_t WS_ROPE = 1 * MiB;
constexpr size_t WS_ZG = 10 * MiB;
constexpr size_t WS_W = 24 * MiB;
constexpr size_t W_INE = WS_W;
constexpr size_t W_OUTE = W_INE + 7 * MiB;
constexpr size_t W_UP0 = W_OUTE + 2 * MiB;
constexpr size_t W_DN0 = W_UP0 + 16 * MiB;
constexpr size_t W_INO = W_DN0 + 16 * MiB;
constexpr size_t W_OUTO = W_INO + 5 * MiB;
constexpr size_t W_W2 = W_OUTO + 2 * MiB;
constexpr size_t W_A2 = W_W2 + 128 * 1024;
constexpr size_t W_G2 = W_A2 + 128 * 1024;
constexpr size_t WS_P = 80 * MiB;
constexpr size_t PE_SZ = 96 * MiB;
constexpr size_t P_QA = WS_P, P_KA = P_QA + PE_SZ, P_VTA = P_KA + PE_SZ, P_QB = P_VTA + PE_SZ, P_KB = P_QB + PE_SZ, P_VTB = P_KB + PE_SZ, P_GB = P_VTB + PE_SZ;
constexpr size_t P_PC = WS_P;
constexpr size_t P_QD = P_PC + 336 * MiB;
constexpr size_t P_KD = P_QD + 96 * MiB;
constexpr size_t P_VTD = P_KD + 24 * MiB;
constexpr size_t WS_YS = 560 * MiB;
constexpr size_t WS_Y = 752 * MiB;
constexpr size_t WS_END = 944 * MiB;
constexpr size_t HID_BLK = 96 * 2048 * 2;

constexpr int SMEM_BYTES = 77824;
constexpr int MAXGRID = 512;

struct Params {
  const float* in[27];
  float* out;
  unsigned char* ws;
  int ph_lo, ph_hi;
};

__device__ __forceinline__ unsigned f2bf(float f) { unsigned u = __builtin_bit_cast(unsigned, f); return (u + 0x7fffu + ((u >> 16) & 1u)) >> 16; }
typedef __bf16 bf2_t __attribute__((ext_vector_type(2)));
__device__ __forceinline__ unsigned pk2(float lo, float hi) { const f32x2 v = (f32x2){lo, hi}; const bf2_t b = __builtin_convertvector(v, bf2_t); return __builtin_bit_cast(unsigned, b); }
__device__ __forceinline__ float bf2f(unsigned short h) { return __builtin_bit_cast(float, (unsigned)h << 16); }
__device__ __forceinline__ float bflo(unsigned u) { return __builtin_bit_cast(float, u << 16); }
__device__ __forceinline__ float bfhi(unsigned u) { return __builtin_bit_cast(float, u & 0xffff0000u); }
__device__ __forceinline__ f32x4 mfma16(bf16x8 a, bf16x8 b, f32x4 c) { return __builtin_amdgcn_mfma_f32_16x16x32_bf16(a, b, c, 0, 0, 0); }
__device__ __forceinline__ float wave_sum(float v) {
#pragma unroll
  for (int o = 1; o < 64; o <<= 1) v += __shfl_xor(v, o);
  return v;
}
__device__ __forceinline__ int opaque_tid() { int t = threadIdx.x; asm volatile("" : "+v"(t)); return t; }
__device__ __forceinline__ void fence_sync() { __builtin_amdgcn_fence(__ATOMIC_RELEASE, "workgroup"); __syncthreads(); __builtin_amdgcn_fence(__ATOMIC_ACQUIRE, "workgroup"); }
__device__ __forceinline__ int seq_start(int t) { return t < TP ? (t & ~16383) : (TP + ((t - TP) & ~2047)); }
__device__ __forceinline__ int seq_len(int t) { return t < TP ? 16384 : 2048; }
__device__ __forceinline__ const float* xin_row(const Params& p, int t) { return t < TP ? p.in[0] + (size_t)t * DM : p.in[1] + (size_t)(t - TP) * DM; }

__device__ __forceinline__ void stage_rc(int b, int& R, int& C) { const int st = b / 1024, sb = b % 1024, swz = sb ^ (((sb >> 9) & 1) << 5); R = (st >> 1) * 16 + swz / 64; C = (st & 1) * 32 + (swz % 64) / 2; }
#define WAIT_V(n) asm volatile("s_waitcnt vmcnt(%0)" ::"n"(n) : "memory")
#define RAW_BARRIER() do { asm volatile("s_waitcnt lgkmcnt(0)" ::: "memory"); __builtin_amdgcn_s_barrier(); asm volatile("" ::: "memory"); } while (0)
template <class Epi>
__device__ __forceinline__ void gemm_multi(const bf16_t* __restrict__ A, size_t lda, const bf16_t* __restrict__ B0, size_t ldb, size_t bstride, int K, int NT, unsigned char* smem, Epi epi) {
  constexpr int STG = 24576;
  const int tid = opaque_tid(), lane = tid & 63, wid = tid >> 6, wr = wid >> 1, wc = wid & 1, fr = lane & 15, fq = lane >> 4;
  __builtin_amdgcn_sched_barrier(0);
  f32x4 acc[3][8];
#pragma unroll
  for (int m = 0; m < 3; ++m)
#pragma unroll
    for (int n = 0; n < 8; ++n) acc[m][n] = (f32x4){0.f, 0.f, 0.f, 0.f};
  const int nk = K >> 5, total = NT * nk;
  const int sb = lane * 16, swz = sb ^ (((sb >> 9) & 1) << 5), Rin = swz >> 6, Cin = (swz & 63) >> 1;
  const bool lowhalf = __builtin_amdgcn_readfirstlane(wid) < 2;
  const bf16_t* gA = A + (size_t)(wid * 16 + Rin) * lda + Cin;
  const bf16_t* gB = B0 + (size_t)(wid * 16 + Rin) * ldb + Cin;
  int ikt = 0;
#define GT_ISSUE(st_) do { unsigned char* d_ = smem + (st_) * STG + tid * 16; const int ko_ = ikt * 32; \
    __builtin_amdgcn_global_load_lds((const unsigned*)(gA + ko_), (unsigned*)(d_), 16, 0, 0); \
    if (lowhalf) __builtin_amdgcn_global_load_lds((const unsigned*)(gA + (size_t)64 * lda + ko_), (unsigned*)(d_ + 4096), 16, 0, 0); \
    _Pragma("unroll") for (int i = 0; i < 4; ++i) __builtin_amdgcn_global_load_lds((const unsigned*)(gB + (size_t)(64 * i) * ldb + ko_), (unsigned*)(d_ + 8192 + i * 4096), 16, 0, 0); \
    if (++ikt == nk) { ikt = 0; gB += bstride; } } while (0)
  GT_ISSUE(0);
  if (total > 1) { GT_ISSUE(1); if (lowhalf) WAIT_V(6); else WAIT_V(5); } else { WAIT_V(0); }
  RAW_BARRIER();
  const int foff = (fr * 64 + fq * 16) ^ ((fr >> 3) << 5);
  int st = 0, kt = 0, nt = 0;
#pragma unroll 1
  for (int g = 0; g < total; ++g) {
    if (g + 2 < total) { const int s2 = st == 0 ? 2 : st - 1; GT_ISSUE(s2); }
    const unsigned char* sA = smem + st * STG + foff;
    bf16x8 af[3], bfr[8];
#pragma unroll
    for (int m = 0; m < 3; ++m) af[m] = *(const bf16x8*)(sA + (wr * 3 + m) * 1024);
#pragma unroll
    for (int n = 0; n < 8; ++n) bfr[n] = *(const bf16x8*)(sA + (8 + wc * 8 + n) * 1024);
#pragma unroll
    for (int m = 0; m < 3; ++m)
#pragma unroll
      for (int n = 0; n < 8; ++n) acc[m][n] = mfma16(bfr[n], af[m], acc[m][n]);
    if (++kt == nk) {
#pragma unroll
      for (int m = 0; m < 3; ++m)
#pragma unroll
        for (int n = 0; n < 8; ++n) { epi(nt, wr * 48 + m * 16 + fr, wc * 128 + n * 16 + fq * 4, acc[m][n]); acc[m][n] = (f32x4){0.f, 0.f, 0.f, 0.f}; }
      kt = 0; ++nt;
    }
    if (g + 2 < total) { if (lowhalf) WAIT_V(6); else WAIT_V(5); } else WAIT_V(0);
    RAW_BARRIER();
    st = st == 2 ? 0 : st + 1;
  }
#undef GT_ISSUE
  __builtin_amdgcn_sched_barrier(0);
}
template <class Epi>
__device__ __forceinline__ void gemm_tile(const bf16_t* __restrict__ A, size_t lda, const bf16_t* __restrict__ B, size_t ldb, int K, unsigned char* smem, Epi epi) {
  gemm_multi(A, lda, B, ldb, 0, K, 1, smem, [&](int, int r, int c, f32x4 v) { epi(r, c, v); });
}

template <class Epi>
__device__ __forceinline__ void gemm192(const bf16_t* __restrict__ A, size_t lda, const bf16_t* __restrict__ Wsub  , int ldb  , int n0, int koff, int K, int NT, unsigned char* smem, Epi epi) {
  constexpr int STG = 28672;
  const int tid = opaque_tid(), lane = tid & 63, wid = tid >> 6, wr = wid >> 1, wc = wid & 1, fr = lane & 15, fq = lane >> 4;
  __builtin_amdgcn_sched_barrier(0);
  f32x4 acc[6][8];
#pragma unroll
  for (int m = 0; m < 6; ++m)
#pragma unroll
    for (int n = 0; n < 8; ++n) acc[m][n] = (f32x4){0.f, 0.f, 0.f, 0.f};
  const int nk = K >> 5, total = NT * nk;
  const int sb = lane * 16, swz = sb ^ (((sb >> 9) & 1) << 5), Rin = swz >> 6, Cin = (swz & 63) >> 1;
  const bf16_t* gA = A + (size_t)(wid * 16 + Rin) * lda + Cin;
  const size_t rb = (size_t)(ldb >> 5) * 1024;
  const int rot = (int)(((__builtin_amdgcn_s_getreg((3 << 11) | 20) & 7u) * (unsigned)NT) >> 3);
  const unsigned char* gB0 = (const unsigned char*)Wsub + ((size_t)(n0 >> 4) * (ldb >> 5) + (koff >> 5)) * 1024 + (size_t)wid * rb + lane * 16;
  int ikt = 0, itile = rot;
#define G192_ISSUE(st_) do { unsigned char* d_ = smem + (st_) * STG + tid * 16; const int ko_ = ikt * 32; \
    _Pragma("unroll") for (int i = 0; i < 3; ++i) __builtin_amdgcn_global_load_lds((const unsigned*)(gA + (size_t)(64 * i) * lda + ko_), (unsigned*)(d_ + i * 4096), 16, 0, 0); \
    { const unsigned char* tb_ = gB0 + (size_t)(itile * 16) * rb + (size_t)ikt * 1024; \
    _Pragma("unroll") for (int i = 0; i < 4; ++i) __builtin_amdgcn_global_load_lds((const unsigned*)(tb_ + (size_t)(4 * i) * rb), (unsigned*)(d_ + 12288 + i * 4096), 16, 0, 0); } \
    if (++ikt == nk) { ikt = 0; if (++itile == NT) itile = 0; } } while (0)
  G192_ISSUE(0);
  WAIT_V(0);
  RAW_BARRIER();
  const int foff = (fr * 64 + fq * 16) ^ ((fr >> 3) << 5);
  int st = 0, kt = 0, nt = rot;
#pragma unroll 1
  for (int g = 0; g < total; ++g) {
    if (g + 1 < total) G192_ISSUE(st ^ 1);
    const unsigned char* sA = smem + st * STG + foff;
    bf16x8 af[6];
#pragma unroll
    for (int m = 0; m < 6; ++m) af[m] = *(const bf16x8*)(sA + (wr * 6 + m) * 1024);
#pragma unroll
    for (int n = 0; n < 8; ++n) {
      const bf16x8 bfr = *(const bf16x8*)(sA + 12288 + (wc * 8 + n) * 1024);
#pragma unroll
      for (int m = 0; m < 6; ++m) acc[m][n] = mfma16(bfr, af[m], acc[m][n]);
    }
    if (++kt == nk) {
#pragma unroll
      for (int m = 0; m < 6; ++m) {
        int rr = wr * 96 + m * 16 + fr; asm volatile("" : "+v"(rr));
#pragma unroll
        for (int n = 0; n < 8; ++n) { epi(nt, rr, wc * 128 + n * 16 + fq * 4, acc[m][n]); acc[m][n] = (f32x4){0.f, 0.f, 0.f, 0.f}; }
        __builtin_amdgcn_sched_barrier(0);
      }
      kt = 0; if (++nt == NT) nt = 0;
    }
    WAIT_V(0);
    RAW_BARRIER();
    st ^= 1;
  }
#undef G192_ISSUE
  __builtin_amdgcn_sched_barrier(0);
}

template <bool SUB>
__device__ __forceinline__ void transpose_item(const float* __restrict__ W, int K, int N, bf16_t* __restrict__ WT, int item, unsigned char* smem) {
  float* s = (float*)smem;
  const int nb = N / 64, kb = item / nb, nn = item % nb, k0 = kb * 64, n0 = nn * 64, tid = threadIdx.x;
#pragma unroll 4
  for (int i = 0; i < 16; ++i) { const int kk = (tid >> 6) + 4 * i, n = tid & 63; s[kk * 65 + n] = W[(size_t)(k0 + kk) * N + n0 + n]; }
  __syncthreads();
  const int kq = tid & 7;
#pragma unroll
  for (int i = 0; i < 2; ++i) {
    const int n = (tid >> 3) + 32 * i;
    u32x4 o;
    o.x = pk2(s[(kq * 8 + 0) * 65 + n], s[(kq * 8 + 1) * 65 + n]); o.y = pk2(s[(kq * 8 + 2) * 65 + n], s[(kq * 8 + 3) * 65 + n]);
    o.z = pk2(s[(kq * 8 + 4) * 65 + n], s[(kq * 8 + 5) * 65 + n]); o.w = pk2(s[(kq * 8 + 6) * 65 + n], s[(kq * 8 + 7) * 65 + n]);
    if (!SUB) *(u32x4*)(WT + (size_t)(n0 + n) * K + k0 + kq * 8) = o;
    else {
      const int nn2 = n0 + n, kk2 = k0 + kq * 8, ob = (nn2 & 15) * 64 + (kk2 & 31) * 2, swz = ob ^ (((ob >> 9) & 1) << 5);
      *(u32x4*)((unsigned char*)WT + ((size_t)(nn2 >> 4) * (K >> 5) + (kk2 >> 5)) * 1024 + swz) = o;
    }
  }
  __syncthreads();
}

__device__ void phase0(const Params& p, unsigned char* smem) {
  unsigned char* ws = p.ws;
  int base = 0;
#define TJOB(SUB_, src_, K_, N_, dst_) do { const int ni = ((K_) / 64) * ((N_) / 64); int first = (int)blockIdx.x - (base % (int)gridDim.x); if (first < 0) first += gridDim.x; \
    for (int it = first; it < ni; it += gridDim.x) transpose_item<SUB_>((src_), (K_), (N_), (bf16_t*)(ws + (dst_)), it, smem); base += ni; } while (0)
  TJOB(true, p.in[8], 1024, 3584, W_INE);
  TJOB(true, p.in[9], 1024, 1024, W_OUTE);
  TJOB(true, p.in[6], 1024, 4096, W_UP0);
  TJOB(true, p.in[6] + (size_t)1024 * 4096, 1024, 4096, W_UP0 + 8 * MiB);
  TJOB(true, p.in[7], 4096, 1024, W_DN0);
  TJOB(true, p.in[7] + (size_t)4096 * 1024, 4096, 1024, W_DN0 + 8 * MiB);
  TJOB(true, p.in[13], 1024, 2560, W_INO);
  TJOB(true, p.in[14], 1024, 1024, W_OUTO);
  TJOB(false, p.in[17], 64, 512, W_W2);
  TJOB(false, p.in[17] + 64 * 512, 64, 512, W_W2 + 64 * 1024);
  TJOB(false, p.in[19], 64, 512, W_A2);
  TJOB(false, p.in[19] + 64 * 512, 64, 512, W_A2 + 64 * 1024);
  TJOB(false, p.in[20], 128, 512, W_G2);
#undef TJOB
  const int gt = blockIdx.x * 256 + threadIdx.x, gs = gridDim.x * 256;
  float* tab = (float*)(ws + WS_TAB);
  for (int i = gt; i < 2 * 8 * 513; i += gs) {
    const int which = i / (8 * 513), i2 = i % (8 * 513), hb = i2 / 513, rel = i2 % 513 - 256;
    const int n = rel < 0 ? -rel : rel;
    int b = rel > 0 ? 16 : 0;
    if (n < 8) b += n;
    else { const int large = 8 + ((31 - __clz(n * n)) - 6); b += large < 15 ? large : 15; }
    float v = p.in[2][b * 8 + hb] * 1.4426950408889634f;
    if (which == 1 && n > 128) v = -1e30f;
    tab[i] = v;
  }
  f32x2* cs = (f32x2*)(ws + WS_ROPE);
  for (int i = gt; i < 16384 * 64; i += gs) {
    const int pos = i >> 6, k = i & 63;
    const float freq = 1.0f / powf(10000.0f, (float)k / 64.0f);
    const float ang = (float)pos * freq;
    const double a = (double)ang;
    const double red = a - 6.283185307179586476925 * floor(a * 0.15915494309189533577);
    cs[i] = (f32x2){(float)cos(red), (float)sin(red)};
  }
}

template <int MODE>
__device__ __forceinline__ void norm_stripe(const Params& p, int t0, const float* __restrict__ g, bf16_t* H) {
  const int tid_ = opaque_tid(), lane = tid_ & 63, wid = tid_ >> 6;
  for (int rr = wid; rr < 96; rr += 4) {
    const int t = t0 + rr;
    const float* src = (MODE == 0) ? xin_row(p, t) : (p.out + (size_t)t * DM);
    f32x4 v[4]; float ss = 0.f;
#pragma unroll
    for (int i = 0; i < 4; ++i) { v[i] = *(const f32x4*)(src + (lane + 64 * i) * 4); ss += v[i].x * v[i].x + v[i].y * v[i].y + v[i].z * v[i].z + v[i].w * v[i].w; }
    ss = wave_sum(ss);
    const float rstd = 1.0f / sqrtf(ss * (1.0f / 1024.0f) + 1e-6f);
#pragma unroll
    for (int i = 0; i < 4; ++i) {
      const f32x4 gv = *(const f32x4*)(g + (lane + 64 * i) * 4);
      const f32x4 o = v[i] * rstd * gv;
      if (MODE == 2) *(f32x4*)(p.out + (size_t)t * DM + (lane + 64 * i) * 4) = o;
      else { u32x2 w; w.x = pk2(o.x, o.y); w.y = pk2(o.z, o.w); *(u32x2*)(H + (size_t)t * DM + (lane + 64 * i) * 4) = w; }
    }
  }
}

template <int NJ, int DVT, bool SWA, bool KSH = false>
__device__ __forceinline__ void attn_item(const bf16_t* __restrict__ Qg, int ldq, const bf16_t* __restrict__ Kg, int ldk, const bf16_t* __restrict__ VTg, int S,
                                          int q0, int kbeg, int kend, const float* __restrict__ tabg  ,
                                          unsigned char* smem, f32x4 (&o)[NJ][DVT], float (&lsum)[NJ]) {
  constexpr int CG = KSH ? 2 : 2 * NJ, NSUBK = 2 * CG, NSUB = NSUBK + DVT, PPT = NSUB / 4, STAGE = NSUB * 1024, TBBYTES = ((NJ * 513 * 4 + 255) / 256) * 256;
  const int tid = opaque_tid(), lane = tid & 63, wid = tid >> 6, fr = lane & 15, fq = lane >> 4;
  float* tb = (float*)smem;
  unsigned char* sbase = smem + TBBYTES;
  for (int i = tid; i < NJ * 513; i += 256) tb[i] = tabg[i];
  bf16x8 qf[NJ][2];
#pragma unroll
  for (int j = 0; j < NJ; ++j)
#pragma unroll
    for (int ks = 0; ks < 2; ++ks) qf[j][ks] = *(const bf16x8*)(Qg + (size_t)(q0 + 16 * wid + fr) * ldq + j * 64 + ks * 32 + fq * 8);
#pragma unroll
  for (int j = 0; j < NJ; ++j) {
    lsum[j] = 0.f;
#pragma unroll
    for (int n = 0; n < DVT; ++n) o[j][n] = (f32x4){0.f, 0.f, 0.f, 0.f};
  }
  const int qpos = q0 + 16 * wid + fr;
  const float c_scale = 0.125f * 1.4426950408889634f;
#pragma unroll
  for (int j = 0; j < NJ; ++j)
#pragma unroll
    for (int ks = 0; ks < 2; ++ks) {
      u32x4 w = __builtin_bit_cast(u32x4, qf[j][ks]);
      w.x = pk2(bflo(w.x) * c_scale, bfhi(w.x) * c_scale); w.y = pk2(bflo(w.y) * c_scale, bfhi(w.y) * c_scale);
      w.z = pk2(bflo(w.z) * c_scale, bfhi(w.z) * c_scale); w.w = pk2(bflo(w.w) * c_scale, bfhi(w.w) * c_scale);
      qf[j][ks] = __builtin_bit_cast(bf16x8, w);
    }
  float bcur[NJ];
#pragma unroll
  for (int j = 0; j < NJ; ++j) bcur[j] = 0.f;
  const int ntile = (kend - kbeg) >> 5;
  const int sb = lane * 16, swz = sb ^ (((sb >> 9) & 1) << 5), Rin = swz >> 6, Cin = (swz & 63) >> 1;
  size_t goff[PPT]; bool isk[PPT];
#pragma unroll
  for (int i = 0; i < PPT; ++i) {
    const int sub = i * 4 + wid;
    isk[i] = sub < NSUBK;
    if (sub < NSUBK) { const int t4 = sub / CG, cg = sub % CG; goff[i] = (size_t)(4 * t4 + 8 * (Rin >> 2) + (Rin & 3)) * ldk + cg * 32 + Cin; }
    else goff[i] = (size_t)((sub - NSUBK) * 16 + Rin) * S + Cin;
  }
#define ATT_ISSUE(t_) do { const int k0_ = kbeg + (t_) * 32; unsigned char* d_ = sbase + ((t_) & 3) * STAGE + tid * 16; \
    _Pragma("unroll") for (int i = 0; i < PPT; ++i) { const bf16_t* g_ = isk[i] ? Kg + (size_t)k0_ * ldk + goff[i] : VTg + k0_ + goff[i]; \
      __builtin_amdgcn_global_load_lds((const unsigned*)g_, (unsigned*)(d_ + i * 4096), 16, 0, 0); } } while (0)
  ATT_ISSUE(0);
  if (ntile > 1) ATT_ISSUE(1);
  if (ntile > 2) ATT_ISSUE(2);
  if (ntile > 2) WAIT_V(2 * PPT); else if (ntile > 1) WAIT_V(PPT); else WAIT_V(0);
  RAW_BARRIER();
  const int foff = (fr * 64 + fq * 16) ^ ((fr >> 3) << 5);
#pragma unroll 1
  for (int kt = 0; kt < ntile; ++kt) {
    const int k0 = kbeg + kt * 32;
    if (kt + 3 < ntile) ATT_ISSUE(kt + 3);
    const unsigned char* sK = sbase + (kt & 3) * STAGE + foff;
    const unsigned char* sV = sK + NSUBK * 1024;
    const bool farL = (k0 + 31 - q0) <= -128, farR = (k0 - (q0 + 63)) >= 128;
    bf16x8 pb[NJ];
#pragma unroll
    for (int j = 0; j < NJ; ++j) {
      f32x4 s[2];
#pragma unroll
      for (int t4 = 0; t4 < 2; ++t4) {
        s[t4] = (f32x4){0.f, 0.f, 0.f, 0.f};
#pragma unroll
        for (int ks = 0; ks < 2; ++ks) {
          const bf16x8 kf = *(const bf16x8*)(sK + (t4 * CG + (KSH ? 0 : j * 2) + ks) * 1024);
          s[t4] = mfma16(kf, qf[j][ks], s[t4]);
        }
      }
      float ps = 0.f;
      if (!SWA && (farL || farR)) {
        const float b = farL ? tb[j * 513] : tb[j * 513 + 512];
        if (b != bcur[j]) {
          const float f = __builtin_amdgcn_exp2f(bcur[j] - b);
#pragma unroll
          for (int n = 0; n < DVT; ++n) o[j][n] = o[j][n] * f;
          lsum[j] *= f; bcur[j] = b;
        }
#pragma unroll
        for (int t4 = 0; t4 < 2; ++t4)
#pragma unroll
          for (int r = 0; r < 4; ++r) { const float e = __builtin_amdgcn_exp2f(s[t4][r]); s[t4][r] = e; ps += e; }
      } else {
        if (bcur[j] != 0.f) {
          const float f = __builtin_amdgcn_exp2f(bcur[j]);
#pragma unroll
          for (int n = 0; n < DVT; ++n) o[j][n] = o[j][n] * f;
          lsum[j] *= f; bcur[j] = 0.f;
        }
        const float* tbj = tb + j * 513 + 256 + (k0 + 8 * fq - qpos);
#pragma unroll
        for (int t4 = 0; t4 < 2; ++t4)
#pragma unroll
          for (int r = 0; r < 4; ++r) { const float e = __builtin_amdgcn_exp2f(s[t4][r] + tbj[4 * t4 + r]); s[t4][r] = e; ps += e; }
      }
      lsum[j] += ps;
      u32x4 w; w.x = pk2(s[0][0], s[0][1]); w.y = pk2(s[0][2], s[0][3]); w.z = pk2(s[1][0], s[1][1]); w.w = pk2(s[1][2], s[1][3]);
      pb[j] = __builtin_bit_cast(bf16x8, w);
    }
#pragma unroll
    for (int n = 0; n < DVT; ++n) {
      const bf16x8 vf = *(const bf16x8*)(sV + n * 1024);
#pragma unroll
      for (int j = 0; j < NJ; ++j) o[j][n] = mfma16(vf, pb[j], o[j][n]);
    }
    if (kt + 3 < ntile) WAIT_V(2 * PPT); else if (kt + 2 < ntile) WAIT_V(PPT); else WAIT_V(0);
    RAW_BARRIER();
  }
#undef ATT_ISSUE
#pragma unroll
  for (int j = 0; j < NJ; ++j) { lsum[j] += __shfl_xor(lsum[j], 16); lsum[j] += __shfl_xor(lsum[j], 32); }
}

__device__ void diff_item(const Params& p, int item, unsigned char* smem) {
  int seq, h, qt;
  if (item < 2048) { seq = item >> 10; h = (item >> 8) & 3; qt = item & 255; }
  else { const int i2 = item - 2048; seq = 2 + (i2 >> 7); h = (i2 >> 5) & 3; qt = i2 & 31; }
  const int S = seq < 2 ? 16384 : 2048, ts = seq < 2 ? seq * 16384 : TP + (seq - 2) * 2048;
  unsigned char* ws = p.ws;
  const bf16_t* Q = (const bf16_t*)(ws + P_QA) + (size_t)ts * 512 + h * 128;
  const bf16_t* Kp = (const bf16_t*)(ws + P_KA) + (size_t)ts * 512 + h * 128;
  const bf16_t* VT = (const bf16_t*)(ws + P_VTA) + (size_t)ts * 512 + (size_t)(h * 128) * S;
  const float* tab = (const float*)(ws + WS_TAB) + (h * 2) * 513;
  f32x4 o[2][8]; float l[2];
  attn_item<2, 8, false>(Q, 512, Kp, 512, VT, S, qt * 64, 0, S, tab, smem, o, l);
  const float* lam = p.in[10];
  float d0 = 0.f, d1 = 0.f;
  for (int i = 0; i < 64; ++i) { d0 += lam[i] * lam[64 + i]; d1 += lam[128 + i] * lam[192 + i]; }
  const float lam_init = 0.2f;
  const float lam_full = expf(d0) - expf(d1) + lam_init;
  const int tid_ = opaque_tid(), lane = tid_ & 63, wid = tid_ >> 6, fr = lane & 15, fq = lane >> 4;
  const float i0 = 1.0f / l[0], i1 = lam_full / l[1];
  float ss = 0.f;
#pragma unroll
  for (int n = 0; n < 8; ++n) { o[0][n] = o[0][n] * i0 - o[1][n] * i1; ss += o[0][n].x * o[0][n].x + o[0][n].y * o[0][n].y + o[0][n].z * o[0][n].z + o[0][n].w * o[0][n].w; }
  ss += __shfl_xor(ss, 16); ss += __shfl_xor(ss, 32);
  const float rstd = (1.0f - lam_init) / sqrtf(ss * (1.0f / 128.0f) + 1e-5f);
  const int t = ts + qt * 64 + 16 * wid + fr;
  bf16_t* Y = (bf16_t*)(ws + WS_Y) + (size_t)t * 1024 + h * 128;
  const float* sub = p.in[11];
#pragma unroll
  for (int n = 0; n < 8; ++n) {
    const f32x4 g = *(const f32x4*)(sub + n * 16 + fq * 4);
    const f32x4 v = o[0][n] * rstd * g;
    u32x2 w; w.x = pk2(v.x, v.y); w.y = pk2(v.z, v.w);
    *(u32x2*)(Y + n * 16 + fq * 4) = w;
  }
}

__device__ void swa_item(const Params& p, int item, unsigned char* smem) {
  const int kvh = item & 1, qtg = item >> 1;
  const int tq = qtg * 64, ts = seq_start(tq), S = seq_len(tq), q0 = tq - ts;
  unsigned char* ws = p.ws;
  const bf16_t* Q = (const bf16_t*)(ws + P_QD) + (size_t)ts * 512 + kvh * 256;
  const bf16_t* Kp = (const bf16_t*)(ws + P_KD) + (size_t)ts * 128 + kvh * 64;
  const bf16_t* VT = (const bf16_t*)(ws + P_VTD) + (size_t)ts * 128 + (size_t)(kvh * 64) * S;
  const float* tab = (const float*)(ws + WS_TAB) + (8 + kvh * 4) * 513;
  int kbeg = q0 - 128; if (kbeg < 0) kbeg = 0;
  int kend = q0 + 64 + 128; if (kend > S) kend = S;
  f32x4 o[4][4]; float l[4];
  attn_item<4, 4, true, true>(Q, 512, Kp, 128, VT, S, q0, kbeg, kend, tab, smem, o, l);
  const int tid_ = opaque_tid(), lane = tid_ & 63, wid = tid_ >> 6, fr = lane & 15, fq = lane >> 4;
  const int t = tq + 16 * wid + fr;
#pragma unroll
  for (int j = 0; j < 4; ++j) {
    const int hq = kvh * 4 + j;
    const float inv = 1.0f / (l[j] + expf(p.in[26][hq]));
    bf16_t* Y = (bf16_t*)(ws + WS_Y) + (size_t)t * 1024 + 512 + hq * 64;
#pragma unroll
    for (int n = 0; n < 4; ++n) {
      const f32x4 v = o[j][n] * inv;
      u32x2 w; w.x = pk2(v.x, v.y); w.y = pk2(v.z, v.w);
      *(u32x2*)(Y + n * 16 + fq * 4) = w;
    }
  }
}

constexpr int RS = 136;
__device__ __forceinline__ void lds_gemm128(f32x4 (&acc)[4][4], const unsigned char* sA, const unsigned char* sB) {
  const int tid_ = opaque_tid(), lane = tid_ & 63, wid = tid_ >> 6, wr = wid >> 1, wc = wid & 1, fr = lane & 15, fq = lane >> 4;
#pragma unroll
  for (int ks = 0; ks < 4; ++ks) {
    bf16x8 af[4], bfr[4];
#pragma unroll
    for (int m = 0; m < 4; ++m) af[m] = *(const bf16x8*)(sA + ((wr * 64 + m * 16 + fr) * RS + ks * 32 + fq * 8) * 2);
#pragma unroll
    for (int n = 0; n < 4; ++n) bfr[n] = *(const bf16x8*)(sB + ((wc * 64 + n * 16 + fr) * RS + ks * 32 + fq * 8) * 2);
#pragma unroll
    for (int m = 0; m < 4; ++m)
#pragma unroll
      for (int n = 0; n < 4; ++n) acc[m][n] = mfma16(bfr[n], af[m], acc[m][n]);
    __builtin_amdgcn_sched_barrier(0);
  }
}
template <bool TRANS, class F>
__device__ __forceinline__ void stage_rope(unsigned char* dst, const bf16_t* __restrict__ src, int pos0, const f32x2* __restrict__ cs, F tokscale) {
  const int tid = opaque_tid();
#pragma unroll 1
  for (int i = 0; i < 4; ++i) {
    const int c = tid + 256 * i, e = c >> 3, i0 = (c & 7) * 8;
    const u32x4 a = *(const u32x4*)(src + (size_t)e * 512 + i0), b = *(const u32x4*)(src + (size_t)e * 512 + 64 + i0);
    const f32x2* cp = cs + (size_t)(pos0 + e) * 64 + i0;
    const float sc = tokscale(e);
    float x1[8] = {bflo(a.x), bfhi(a.x), bflo(a.y), bfhi(a.y), bflo(a.z), bfhi(a.z), bflo(a.w), bfhi(a.w)};
    float x2[8] = {bflo(b.x), bfhi(b.x), bflo(b.y), bfhi(b.y), bflo(b.z), bfhi(b.z), bflo(b.w), bfhi(b.w)};
    float o1[8], o2[8];
#pragma unroll
    for (int k = 0; k < 8; ++k) { const f32x2 w = cp[k]; o1[k] = (x1[k] * w.x - x2[k] * w.y) * sc; o2[k] = (x1[k] * w.y + x2[k] * w.x) * sc; }
    if (!TRANS) {
      u32x4 w1, w2;
      w1.x = pk2(o1[0], o1[1]); w1.y = pk2(o1[2], o1[3]); w1.z = pk2(o1[4], o1[5]); w1.w = pk2(o1[6], o1[7]);
      w2.x = pk2(o2[0], o2[1]); w2.y = pk2(o2[2], o2[3]); w2.z = pk2(o2[4], o2[5]); w2.w = pk2(o2[6], o2[7]);
      *(u32x4*)(dst + (e * RS + i0) * 2) = w1; *(u32x4*)(dst + (e * RS + 64 + i0) * 2) = w2;
    } else {
#pragma unroll
      for (int k = 0; k < 8; ++k) { *(bf16_t*)(dst + ((i0 + k) * RS + e) * 2) = (bf16_t)f2bf(o1[k]); *(bf16_t*)(dst + ((64 + i0 + k) * RS + e) * 2) = (bf16_t)f2bf(o2[k]); }
    }
  }
}
__device__ __forceinline__ void stage_bf16(unsigned char* dst, const bf16_t* __restrict__ src, size_t ld) {
  const int tid = opaque_tid();
#pragma unroll 4
  for (int i = 0; i < 8; ++i) { const int c = tid + 256 * i, r = c >> 4, kc = c & 15; *(u32x4*)(dst + (r * RS + kc * 8) * 2) = *(const u32x4*)(src + (size_t)r * ld + kc * 8); }
}
__device__ __forceinline__ void stage_f32(unsigned char* dst, const float* __restrict__ src) {
  const int tid = opaque_tid();
#pragma unroll 2
  for (int i = 0; i < 8; ++i) {
    const int c = tid + 256 * i, r = c >> 4, kc = c & 15;
    const f32x4 a = *(const f32x4*)(src + r * 128 + kc * 8), b = *(const f32x4*)(src + r * 128 + kc * 8 + 4);
    u32x4 w; w.x = pk2(a.x, a.y); w.y = pk2(a.z, a.w); w.z = pk2(b.x, b.y); w.w = pk2(b.z, b.w);
    *(u32x4*)(dst + (r * RS + kc * 8) * 2) = w;
  }
}
__device__ __forceinline__ float ret_logg(const Params& p, int dir, int h) {
  const float x = p.in[12][dir * 4 + h];
  return -(x > 20.f ? x : log1pf(expf(x)));
}

__device__ void retU_item(const Params& p, int item, unsigned char* smem) {
  const int gc = item >> 2, h = item & 3, t0 = gc * 128, ts = seq_start(t0), S = seq_len(t0), pos0 = t0 - ts;
  unsigned char* ws = p.ws;
  unsigned char* bufA = smem; unsigned char* bufB = smem + 128 * RS * 2;
  const f32x2* cs = (const f32x2*)(ws + WS_ROPE);
  const bf16_t* Kp = (const bf16_t*)(ws + P_KB) + (size_t)t0 * 512 + h * 128;
  const bf16_t* VT = (const bf16_t*)(ws + P_VTB) + (size_t)ts * 512 + (size_t)(h * 128) * S + pos0;
  const int tid_ = opaque_tid(), lane = tid_ & 63, wid = tid_ >> 6, wr = wid >> 1, wc = wid & 1, fr = lane & 15, fq = lane >> 4;
  stage_bf16(bufA, VT, (size_t)S);
#pragma unroll 1
  for (int dir = 0; dir < 2; ++dir) {
    const float lg = ret_logg(p, dir, h) * 1.4426950408889634f;
    stage_rope<true>(bufB, Kp, pos0, cs, [&](int e) { return 0.08838834764831845f * __builtin_amdgcn_exp2f(lg * (dir == 0 ? (float)(127 - e) : (float)e)); });
    __syncthreads();
    f32x4 acc[4][4];
#pragma unroll
    for (int m = 0; m < 4; ++m)
#pragma unroll
      for (int n = 0; n < 4; ++n) acc[m][n] = (f32x4){0.f, 0.f, 0.f, 0.f};
    lds_gemm128(acc, bufA, bufB);
    float* U = p.out + ((size_t)(gc * 4 + h) * 2 + dir) * 16384;
#pragma unroll
    for (int m = 0; m < 4; ++m)
#pragma unroll
      for (int n = 0; n < 4; ++n) *(f32x4*)(U + (wr * 64 + m * 16 + fr) * 128 + wc * 64 + n * 16 + fq * 4) = acc[m][n];
    __syncthreads();
  }
}

__device__ void ret_scan(const Params& p) {
  const int total = 34 * 4 * 2 * 4096;
  for (int i = blockIdx.x * 256 + threadIdx.x; i < total; i += gridDim.x * 256) {
    const int e4 = i & 4095, sd = i >> 12, dir = sd & 1, h = (sd >> 1) & 3, seq = sd >> 3;
    const int nc = seq < 2 ? 128 : 16, gc0 = seq < 2 ? seq * 128 : 256 + (seq - 2) * 16;
    const float gC = expf(128.0f * ret_logg(p, dir, h));
    f32x4 carry = (f32x4){0.f, 0.f, 0.f, 0.f};
    for (int c = 0; c < nc; ++c) {
      const int cc = dir == 0 ? c : nc - 1 - c;
      f32x4* R = (f32x4*)(p.out + ((size_t)((gc0 + cc) * 4 + h) * 2 + dir) * 16384) + e4;
      const f32x4 u = *R;
      *R = carry;
      carry = carry * gC + u;
    }
  }
}

__device__ void retO_item(const Params& p, int item, unsigned char* smem) {
  const int gc = item >> 2, h = item & 3, t0 = gc * 128, ts = seq_start(t0), S = seq_len(t0), pos0 = t0 - ts;
  unsigned char* ws = p.ws;
  unsigned char* bufA = smem; unsigned char* bufB = smem + 128 * RS * 2;
  const f32x2* cs = (const f32x2*)(ws + WS_ROPE);
  const bf16_t* Qp = (const bf16_t*)(ws + P_QB) + (size_t)t0 * 512 + h * 128;
  const bf16_t* Kp = (const bf16_t*)(ws + P_KB) + (size_t)t0 * 512 + h * 128;
  const bf16_t* VT = (const bf16_t*)(ws + P_VTB) + (size_t)ts * 512 + (size_t)(h * 128) * S + pos0;
  const float* R0 = p.out + ((size_t)(gc * 4 + h) * 2 + 0) * 16384;
  const float* R1 = R0 + 16384;
  const int tid_ = opaque_tid(), lane = tid_ & 63, wid = tid_ >> 6, wr = wid >> 1, wc = wid & 1, fr = lane & 15, fq = lane >> 4;
  const float lg0 = ret_logg(p, 0, h) * 1.4426950408889634f, lg1 = ret_logg(p, 1, h) * 1.4426950408889634f;
  f32x4 acc[4][4];
  bf16_t* pscr = (bf16_t*)(ws + WS_END + (size_t)blockIdx.x * 32768);
#define ZERO44(a_) _Pragma("unroll") for (int m = 0; m < 4; ++m) _Pragma("unroll") for (int n = 0; n < 4; ++n) a_[m][n] = (f32x4){0.f, 0.f, 0.f, 0.f}
  stage_rope<false>(bufA, Qp, pos0, cs, [](int) { return 1.0f; });
  stage_rope<false>(bufB, Kp, pos0, cs, [](int) { return 0.08838834764831845f; });
  __syncthreads();
  ZERO44(acc);
  lds_gemm128(acc, bufA, bufB);
#pragma unroll
  for (int m = 0; m < 4; ++m)
#pragma unroll
    for (int n = 0; n < 4; ++n) {
      const int i = wr * 64 + m * 16 + fr, e0 = wc * 64 + n * 16 + fq * 4;
      float v[4];
#pragma unroll
      for (int r = 0; r < 4; ++r) {
        const int d = i - (e0 + r);
        const float mm = d > 0 ? __builtin_amdgcn_exp2f(lg0 * (float)d) : (d < 0 ? __builtin_amdgcn_exp2f(lg1 * (float)(-d)) : 2.0f);
        v[r] = acc[m][n][r] * mm;
      }
      u32x2 w; w.x = pk2(v[0], v[1]); w.y = pk2(v[2], v[3]);
      *(u32x2*)(pscr + i * 128 + e0) = w;
    }
  fence_sync();
  stage_rope<false>(bufA, Qp, pos0, cs, [&](int e) { return __builtin_amdgcn_exp2f(lg0 * (float)(e + 1)); });
  stage_f32(bufB, R0);
  __syncthreads();
  ZERO44(acc);
  lds_gemm128(acc, bufA, bufB);
  __syncthreads();
  stage_rope<false>(bufA, Qp, pos0, cs, [&](int e) { return __builtin_amdgcn_exp2f(lg1 * (float)(128 - e)); });
  stage_f32(bufB, R1);
  __syncthreads();
  lds_gemm128(acc, bufA, bufB);
  __syncthreads();
  stage_bf16(bufA, pscr, 128);
  stage_bf16(bufB, VT, (size_t)S);
  __syncthreads();
  lds_gemm128(acc, bufA, bufB);
  __syncthreads();
  float* red = (float*)bufB;
#pragma unroll
  for (int m = 0; m < 4; ++m) {
    float ss = 0.f;
#pragma unroll
    for (int n = 0; n < 4; ++n) ss += acc[m][n].x * acc[m][n].x + acc[m][n].y * acc[m][n].y + acc[m][n].z * acc[m][n].z + acc[m][n].w * acc[m][n].w;
    ss += __shfl_xor(ss, 16); ss += __shfl_xor(ss, 32);
    if (fq == 0) red[(wr * 64 + m * 16 + fr) * 2 + wc] = ss;
  }
  __syncthreads();
  const bf16_t* G = (const bf16_t*)(ws + P_GB);
  bf16_t* Y = (bf16_t*)(ws + WS_Y);
#pragma unroll
  for (int m = 0; m < 4; ++m) {
    const int i = wr * 64 + m * 16 + fr;
    const float rstd = 1.0f / sqrtf((red[i * 2] + red[i * 2 + 1]) * (1.0f / 128.0f) + 1e-6f);
#pragma unroll
    for (int n = 0; n < 4; ++n) {
      const int col = h * 128 + wc * 64 + n * 16 + fq * 4;
      const u32x2 gw = *(const u32x2*)(G + (size_t)(t0 + i) * 512 + col);
      const float g[4] = {bflo(gw.x), bfhi(gw.x), bflo(gw.y), bfhi(gw.y)};
      float v[4];
#pragma unroll
      for (int r = 0; r < 4; ++r) v[r] = acc[m][n][r] * rstd * (g[r] / (1.0f + expf(-g[r])));
      u32x2 w; w.x = pk2(v[0], v[1]); w.y = pk2(v[2], v[3]);
      *(u32x2*)(Y + (size_t)(t0 + i) * 1024 + 512 + col) = w;
    }
  }
  __syncthreads();
#undef ZERO44
}

__device__ __forceinline__ float dpp_xor1(float v) { return __builtin_bit_cast(float, __builtin_amdgcn_update_dpp(0, __builtin_bit_cast(int, v), 0xB1, 0xF, 0xF, true)); }
__device__ __forceinline__ float dpp_xor2(float v) { return __builtin_bit_cast(float, __builtin_amdgcn_update_dpp(0, __builtin_bit_cast(int, v), 0x4E, 0xF, 0xF, true)); }

__device__ __forceinline__ float dpp_hmirror(float v) { return __builtin_bit_cast(float, __builtin_amdgcn_update_dpp(0, __builtin_bit_cast(int, v), 0x141, 0xF, 0xF, true)); }
__device__ __forceinline__ float dpp_mirror(float v) { return __builtin_bit_cast(float, __builtin_amdgcn_update_dpp(0, __builtin_bit_cast(int, v), 0x140, 0xF, 0xF, true)); }
__device__ __forceinline__ float red16(float v) { v += dpp_xor1(v); v += dpp_xor2(v); v += dpp_hmirror(v); v += dpp_mirror(v); return v; }
__device__ __forceinline__ float wave_sum_fast(float v) { v = red16(v); v += __shfl_xor(v, 16); v += __shfl_xor(v, 32); return v; }
__device__ __forceinline__ float red8(float v) { v += dpp_xor1(v); v += dpp_xor2(v); v += dpp_hmirror(v); return v; }

template <bool DUAL>
__device__ __forceinline__ void rwkv_chain(const Params& p, int z, int seq, int h, int ci_beg, int ci_end, int mode, const float* st_in, float* st_out, float* st_out2, unsigned char* smem) {
  const int S = seq < 2 ? 16384 : 2048, ts = seq < 2 ? seq * 16384 : TP + (seq - 2) * 2048;
  unsigned char* ws = p.ws;
  const bf16_t* PC = (const bf16_t*)(ws + P_PC) + (size_t)ts * 1792;
  bf16_t* YS = (bf16_t*)(ws + WS_YS) + (size_t)z * T * 512 + (size_t)ts * 512 + h * 64;
  const bf16_t* w2T = (const bf16_t*)(ws + W_W2) + (size_t)(z * 512 + h * 64) * 64;
  const bf16_t* a2T = (const bf16_t*)(ws + W_A2) + (size_t)(z * 512 + h * 64) * 64;
  float* sR = (float*)smem;
  float* sKP = sR + 1024;
  float* sKA = sKP + 1024;
  float* sV = sKA + 1024;
  float* sW = sV + 1024;
  float* sKB = sW + 1024;
  float* sKM = sKB + 1024;
  float* sYO = sKM + 1024;
  float* sBon = sYO + 1024;
  unsigned char* sTW = (unsigned char*)(sBon + 64);
  unsigned char* sTA = sTW + 16 * 144;
  float* sYP = (float*)(sTA + 16 * 144);
  float* sV2 = sYP + 16 * 64 * 8;
  const int tid = opaque_tid(), lane = tid & 63, wid = tid >> 6, fr = lane & 15, fq = lane >> 4;
  const int j = lane;
  const int cg5[5] = {h * 64 + j, 512 + h * 64 + j, 1024 + h * 64 + j, 1536 + j, 1600 + j};
  float mu0[5], mu1[5];
#pragma unroll
  for (int g = 0; g < 5; ++g) { mu0[g] = p.in[15][cg5[g]]; mu1[g] = p.in[15][1792 + cg5[g]]; }
  const float kkw = p.in[21][h * 64 + j];
  const int cj = h * 64 + wid * 16 + fr;
  const float c_ka = p.in[22][cj], c_rk = p.in[23][cj], c_w0 = p.in[16][z * 512 + cj], c_a0 = p.in[18][z * 512 + cj];
  bf16x8 bw[2], ba[2];
#pragma unroll
  for (int ks = 0; ks < 2; ++ks) { bw[ks] = *(const bf16x8*)(w2T + (size_t)(wid * 16 + fr) * 64 + ks * 32 + fq * 8); ba[ks] = *(const bf16x8*)(a2T + (size_t)(wid * 16 + fr) * 64 + ks * 32 + fq * 8); }
  const int q8 = lane & 7, row0 = wid * 16 + 2 * (lane >> 3);
  f32x2 st[2][4];
#pragma unroll
  for (int r = 0; r < 2; ++r)
#pragma unroll
    for (int c = 0; c < 4; ++c) {
      if (mode == 3) st[r][c] = *(const f32x2*)(st_in + (row0 + r) * 64 + q8 * 8 + 2 * c);
      else if (mode == 2) st[r][c] = (f32x2){(row0 + r) == (q8 * 8 + 2 * c) ? 1.f : 0.f, (row0 + r) == (q8 * 8 + 2 * c + 1) ? 1.f : 0.f};
      else st[r][c] = (f32x2){0.f, 0.f};
    }
  f32x2 sp[2][4];
#pragma unroll
  for (int r = 0; r < 2; ++r)
#pragma unroll
    for (int c = 0; c < 4; ++c) sp[r][c] = (f32x2){(row0 + r) == (q8 * 8 + 2 * c) ? 1.f : 0.f, (row0 + r) == (q8 * 8 + 2 * c + 1) ? 1.f : 0.f};
  const float vmul = mode == 2 ? 0.f : 1.f;
  const bool wout = (mode == 0 || mode == 3);
  u32x2 pend_w = (u32x2){0u, 0u}; long pend_off = -1;
  unsigned short raw[5][6];
#define RWKV_LOAD(ci_) do { const int p0_ = z == 0 ? (ci_) * 16 : S - 16 - (ci_) * 16; \
    _Pragma("unroll") for (int k = 0; k < 6; ++k) { int pos_ = z == 0 ? p0_ + 4 * wid - 1 + k : p0_ + 16 - 4 * wid - k; pos_ = pos_ < 0 ? 0 : (pos_ > S - 1 ? S - 1 : pos_); \
      _Pragma("unroll") for (int g = 0; g < 5; ++g) raw[g][k] = PC[(size_t)pos_ * 1792 + cg5[g]]; } } while (0)
  RWKV_LOAD(ci_beg);
#pragma unroll 1
  for (int ci = ci_beg; ci < ci_end; ++ci) {
    const int p0 = z == 0 ? ci * 16 : S - 16 - ci * 16;
    float* sVc = (ci & 1) ? sV2 : sV;
#pragma unroll
    for (int u = 0; u < 4; ++u) {
      const int s = wid * 4 + u, pos = z == 0 ? p0 + s : p0 + 15 - s;
      float x[5];
#pragma unroll
      for (int g = 0; g < 5; ++g) {
        const float xc = bf2f(raw[g][1 + u]);
        const float xa = bf2f(raw[g][u]), xb = bf2f(raw[g][2 + u]);
        const float xp = pos > 0 ? (z == 0 ? xa : xb) : 0.f;
        const float xn = pos < S - 1 ? (z == 0 ? xb : xa) : 0.f;
        x[g] = xc + mu0[g] * (xp - xc) + mu1[g] * (xn - xc);
      }
      sR[s * 64 + j] = x[0]; sKP[s * 64 + j] = x[1]; sVc[s * 64 + j] = x[2];
      const float kr = x[1] * kkw;
      const float nn = wave_sum_fast(kr * kr);
      sKA[s * 64 + j] = -kr * __builtin_amdgcn_rsqf(fmaxf(nn, 1e-24f));
      const float xz = fminf(fmaxf(x[3], -15.f), 15.f);
      const float e2 = __expf(2.0f * xz);
      *(bf16_t*)(sTW + (s * 72 + j) * 2) = (bf16_t)f2bf((e2 - 1.0f) * __builtin_amdgcn_rcpf(e2 + 1.0f));
      *(bf16_t*)(sTA + (s * 72 + j) * 2) = (bf16_t)f2bf(x[4]);
    }
    __syncthreads();
    {
      f32x4 dw = (f32x4){0.f, 0.f, 0.f, 0.f}, da = dw;
#pragma unroll
      for (int ks = 0; ks < 2; ++ks) {
        const bf16x8 aw = *(const bf16x8*)(sTW + (fr * 72 + ks * 32 + fq * 8) * 2);
        const bf16x8 aa = *(const bf16x8*)(sTA + (fr * 72 + ks * 32 + fq * 8) * 2);
        dw = mfma16(aw, bw[ks], dw); da = mfma16(aa, ba[ks], da);
      }
      const int col = wid * 16 + fr;
#pragma unroll
      for (int r = 0; r < 4; ++r) {
        const int s = 4 * fq + r;
        const float wl = c_w0 + dw[r];
        const float w = __expf(-0.6065306597126334f * __builtin_amdgcn_rcpf(1.0f + __expf(-wl)));
        const float a = __builtin_amdgcn_rcpf(1.0f + __expf(-(c_a0 + da[r])));
        const float kp = sKP[s * 64 + col], kk = -sKA[s * 64 + col], rr = sR[s * 64 + col];
        const float km = kp * (1.0f + (a - 1.0f) * c_ka);
        sW[s * 64 + col] = w; sKB[s * 64 + col] = kk * a; sKM[s * 64 + col] = km;
        const float bp = red16(rr * km * c_rk);
        if (fr == 0) sBon[wid * 16 + s] = bp;
      }
    }
    __syncthreads();
    if (pend_off >= 0) *(u32x2*)(YS + pend_off) = pend_w;
    if (ci + 1 < ci_end) RWKV_LOAD(ci + 1);
    f32x4 opn[10]; f32x2 vvn; float bonn;
#define RWKV_OPLOAD(s_) do { const int s__ = (s_); \
      opn[0] = *(const f32x4*)(sW + s__ * 64 + q8 * 8); opn[1] = *(const f32x4*)(sW + s__ * 64 + q8 * 8 + 4); \
      opn[2] = *(const f32x4*)(sKA + s__ * 64 + q8 * 8); opn[3] = *(const f32x4*)(sKA + s__ * 64 + q8 * 8 + 4); \
      opn[4] = *(const f32x4*)(sKB + s__ * 64 + q8 * 8); opn[5] = *(const f32x4*)(sKB + s__ * 64 + q8 * 8 + 4); \
      opn[6] = *(const f32x4*)(sKM + s__ * 64 + q8 * 8); opn[7] = *(const f32x4*)(sKM + s__ * 64 + q8 * 8 + 4); \
      opn[8] = *(const f32x4*)(sR + s__ * 64 + q8 * 8); opn[9] = *(const f32x4*)(sR + s__ * 64 + q8 * 8 + 4); \
      vvn = *(const f32x2*)(sVc + s__ * 64 + row0); bonn = (sBon[s__] + sBon[16 + s__]) + (sBon[32 + s__] + sBon[48 + s__]); } while (0)
    RWKV_OPLOAD(0);
#pragma unroll 2
    for (int s = 0; s < 16; ++s) {
      const f32x4 w0 = opn[0], w1 = opn[1], a0 = opn[2], a1 = opn[3], b0 = opn[4], b1 = opn[5], m0 = opn[6], m1 = opn[7], r0 = opn[8], r1 = opn[9];
      const f32x2 vv = vvn * vmul; const float bon = bonn;
      if (s < 15) RWKV_OPLOAD(s + 1);
      const f32x2 W2[4] = {(f32x2){w0.x, w0.y}, (f32x2){w0.z, w0.w}, (f32x2){w1.x, w1.y}, (f32x2){w1.z, w1.w}};
      const f32x2 A2[4] = {(f32x2){a0.x, a0.y}, (f32x2){a0.z, a0.w}, (f32x2){a1.x, a1.y}, (f32x2){a1.z, a1.w}};
      const f32x2 B2[4] = {(f32x2){b0.x, b0.y}, (f32x2){b0.z, b0.w}, (f32x2){b1.x, b1.y}, (f32x2){b1.z, b1.w}};
      const f32x2 M2[4] = {(f32x2){m0.x, m0.y}, (f32x2){m0.z, m0.w}, (f32x2){m1.x, m1.y}, (f32x2){m1.z, m1.w}};
      const f32x2 R2[4] = {(f32x2){r0.x, r0.y}, (f32x2){r0.z, r0.w}, (f32x2){r1.x, r1.y}, (f32x2){r1.z, r1.w}};
      if constexpr (DUAL) {
#pragma unroll
        for (int r = 0; r < 2; ++r) {
          const float vi = r == 0 ? vv.x : vv.y;
          f32x2 sacc = st[r][0] * A2[0], pacc = sp[r][0] * A2[0];
#pragma unroll
          for (int c = 1; c < 4; ++c) { sacc = st[r][c] * A2[c] + sacc; pacc = sp[r][c] * A2[c] + pacc; }
          const float sa = red8(sacc.x + sacc.y), pa = red8(pacc.x + pacc.y);
          const f32x2 sa2 = (f32x2){sa, sa}, vi2 = (f32x2){vi, vi}, pa2 = (f32x2){pa, pa};
#pragma unroll
          for (int c = 0; c < 4; ++c) {
            st[r][c] = st[r][c] * W2[c] + (sa2 * B2[c] + vi2 * M2[c]);
            sp[r][c] = sp[r][c] * W2[c] + pa2 * B2[c];
          }
        }
      } else {
      float yy[2];
#pragma unroll
      for (int r = 0; r < 2; ++r) {
        const float vi = r == 0 ? vv.x : vv.y;
        f32x2 sacc = st[r][0] * A2[0];
#pragma unroll
        for (int c = 1; c < 4; ++c) sacc = st[r][c] * A2[c] + sacc;
        const float sa = red8(sacc.x + sacc.y);
        const f32x2 sa2 = (f32x2){sa, sa}, vi2 = (f32x2){vi, vi};
        f32x2 yacc = (f32x2){0.f, 0.f};
#pragma unroll
        for (int c = 0; c < 4; ++c) {
          st[r][c] = st[r][c] * W2[c] + (sa2 * B2[c] + vi2 * M2[c]);
          yacc = st[r][c] * R2[c] + yacc;
        }
        yy[r] = yacc.x + yacc.y;
      }
      sYP[(s * 64 + row0) * 8 + q8] = yy[0]; sYP[(s * 64 + row0 + 1) * 8 + q8] = yy[1];
      }
    }
#undef RWKV_OPLOAD
    __syncthreads();
    if (wout) {
      const int s = tid >> 4, c4 = (tid & 15) * 4, pos = z == 0 ? p0 + s : p0 + 15 - s;
      const float bon = (sBon[s] + sBon[16 + s]) + (sBon[32 + s] + sBon[48 + s]);
      const f32x4 vv4 = *(const f32x4*)(sVc + s * 64 + c4);
      float yo[4];
#pragma unroll
      for (int r = 0; r < 4; ++r) {
        const f32x4 a = *(const f32x4*)(sYP + (s * 64 + c4 + r) * 8), b = *(const f32x4*)(sYP + (s * 64 + c4 + r) * 8 + 4);
        yo[r] = ((a.x + a.y) + (a.z + a.w)) + ((b.x + b.y) + (b.z + b.w)) + bon * vv4[r];
      }
      pend_w.x = pk2(yo[0], yo[1]); pend_w.y = pk2(yo[2], yo[3]);
      pend_off = (long)pos * 512 + c4;
    }
  }
  if (pend_off >= 0) *(u32x2*)(YS + pend_off) = pend_w;
  if (mode == 1 || mode == 2) {
#pragma unroll
    for (int r = 0; r < 2; ++r) {
      *(f32x4*)(st_out + (row0 + r) * 64 + q8 * 8) = (f32x4){st[r][0].x, st[r][0].y, st[r][1].x, st[r][1].y};
      *(f32x4*)(st_out + (row0 + r) * 64 + q8 * 8 + 4) = (f32x4){st[r][2].x, st[r][2].y, st[r][3].x, st[r][3].y};
      if constexpr (DUAL) {
        *(f32x4*)(st_out2 + (row0 + r) * 64 + q8 * 8) = (f32x4){sp[r][0].x, sp[r][0].y, sp[r][1].x, sp[r][1].y};
        *(f32x4*)(st_out2 + (row0 + r) * 64 + q8 * 8 + 4) = (f32x4){sp[r][2].x, sp[r][2].y, sp[r][3].x, sp[r][3].y};
      }
    }
  }
#undef RWKV_LOAD
  __syncthreads();
}

constexpr size_t WS_RL = WS_END + 16 * MiB, WS_RPHI = WS_RL + 8 * MiB, WS_RS = WS_RPHI + 8 * MiB;
__device__ void rwkv_combine(const Params& p, int ch, unsigned char* smem) {
  float* sS = (float*)smem;
  const int tid = opaque_tid(), jcol = tid & 63, ig = tid >> 6;
  const float* L = (const float*)(p.ws + WS_RL) + (size_t)ch * 16 * 4096;
  const float* PH = (const float*)(p.ws + WS_RPHI) + (size_t)ch * 16 * 4096;
  float* SO = (float*)(p.ws + WS_RS) + (size_t)ch * 16 * 4096;
  float cur[16];
#pragma unroll
  for (int r = 0; r < 16; ++r) cur[r] = 0.f;
#pragma unroll 1
  for (int k = 0; k < 16; ++k) {
#pragma unroll
    for (int r = 0; r < 16; ++r) { SO[(size_t)k * 4096 + (ig * 16 + r) * 64 + jcol] = cur[r]; sS[(ig * 16 + r) * 65 + jcol] = cur[r]; }
    __syncthreads();
    if (k < 15) {
      float acc[16];
#pragma unroll
      for (int r = 0; r < 16; ++r) acc[r] = L[(size_t)k * 4096 + (ig * 16 + r) * 64 + jcol];
#pragma unroll 4
      for (int m = 0; m < 64; ++m) {
        const float ph = PH[(size_t)k * 4096 + m * 64 + jcol];
#pragma unroll
        for (int r = 0; r < 16; ++r) acc[r] += sS[(ig * 16 + r) * 65 + m] * ph;
      }
#pragma unroll
      for (int r = 0; r < 16; ++r) cur[r] = acc[r];
    }
    __syncthreads();
  }
}

__device__ __forceinline__ int next_item(unsigned* ctr, unsigned char* smem) {
  volatile int* slot = (volatile int*)(smem + SMEM_BYTES - 16);
  __syncthreads();
  if (threadIdx.x == 0) *slot = (int)atomicAdd(ctr, 1u);
  __syncthreads();
  return *slot;
}

__device__ void phase1(const Params& p, unsigned char* smem) {
  unsigned char* ws = p.ws;
  bf16_t* H = (bf16_t*)(ws + WS_Y);
  const bf16_t* W = (const bf16_t*)(ws + W_INE);
  for (int sp = blockIdx.x; sp < NSTRIPE / 2; sp += gridDim.x) {
    const int t0 = sp * 192;
    norm_stripe<0>(p, t0, p.in[3], H); norm_stripe<0>(p, t0 + 96, p.in[3], H);
    fence_sync();
    gemm192(H + (size_t)t0 * DM, DM, W, DM, 0, 0, DM, 14, smem, [&](int nt, int r, int c, f32x4 v) {
      const int t = t0 + r, arr = nt >> 1, cb = (nt & 1) * 256 + c;
      bf16_t* dst = (bf16_t*)(ws + WS_P + (size_t)arr * PE_SZ);
      if (!(arr == 2 || arr == 5)) { u32x2 w; w.x = pk2(v.x, v.y); w.y = pk2(v.z, v.w); *(u32x2*)(dst + (size_t)t * 512 + cb) = w; }
      else {
        const int ts = seq_start(t), S = seq_len(t), pos = t - ts;
        bf16_t* d = dst + (size_t)ts * 512 + (size_t)cb * S + pos;
        d[0] = (bf16_t)f2bf(v.x); d[S] = (bf16_t)f2bf(v.y); d[2 * (size_t)S] = (bf16_t)f2bf(v.z); d[3 * (size_t)S] = (bf16_t)f2bf(v.w);
      }
    });
    fence_sync();
  }
}

template <int LAYER, int NQ>
__device__ __forceinline__ void ffn_stripe(const Params& p, int t0, unsigned char* smem, bf16_t* H, bf16_t* hid) {
  constexpr int HC = 4096 / NQ;
  unsigned char* ws = p.ws;
  const bf16_t* Wup = (const bf16_t*)(ws + W_UP0 + (size_t)LAYER * 8 * MiB);
  const bf16_t* Wdn = (const bf16_t*)(ws + W_DN0 + (size_t)LAYER * 8 * MiB);
#pragma unroll 1
  for (int q = 0; q < NQ; ++q) {
    gemm192(H + (size_t)t0 * DM, DM, Wup, DM, q * HC, 0, DM, HC / 256, smem, [&](int nt, int r, int c, f32x4 v) {
      v.x = v.x > 0.f ? v.x * v.x : 0.f; v.y = v.y > 0.f ? v.y * v.y : 0.f; v.z = v.z > 0.f ? v.z * v.z : 0.f; v.w = v.w > 0.f ? v.w * v.w : 0.f;
      u32x2 w; w.x = pk2(v.x, v.y); w.y = pk2(v.z, v.w);
      *(u32x2*)(hid + (size_t)r * HC + nt * 256 + c) = w;
    });
    fence_sync();
    gemm192(hid, HC, Wdn, DFF, 0, q * HC, HC, 4, smem, [&](int nt, int r, int c, f32x4 v) {
      float* d = p.out + (size_t)(t0 + r) * DM + nt * 256 + c;
      *(f32x4*)d = *(const f32x4*)d + v;
    });
    fence_sync();
  }
}

__device__ void phase5(const Params& p, unsigned char* smem) {
  unsigned char* ws = p.ws;
  bf16_t* Y = (bf16_t*)(ws + WS_Y);
  bf16_t* hid = (bf16_t*)(ws + WS_YS + (size_t)blockIdx.x * HID_BLK);
  const bf16_t* Wo = (const bf16_t*)(ws + W_OUTE);
  const bf16_t* Wi = (const bf16_t*)(ws + W_INO);
  for (int sp = blockIdx.x; sp < NSTRIPE / 2; sp += gridDim.x) {
    const int t0 = sp * 192;
    gemm192(Y + (size_t)t0 * DM, DM, Wo, DM, 0, 0, DM, 4, smem, [&](int nt, int r, int c, f32x4 v) {
      const int t = t0 + r;
      const f32x4 xi = *(const f32x4*)(xin_row(p, t) + nt * 256 + c);
      *(f32x4*)(p.out + (size_t)t * DM + nt * 256 + c) = xi + v;
    });
    fence_sync();
    norm_stripe<1>(p, t0, p.in[4], Y); norm_stripe<1>(p, t0 + 96, p.in[4], Y);
    fence_sync();
    ffn_stripe<0, 4>(p, t0, smem, Y, hid);
    norm_stripe<1>(p, t0, p.in[3] + DM, Y); norm_stripe<1>(p, t0 + 96, p.in[3] + DM, Y);
    fence_sync();
    gemm192(Y + (size_t)t0 * DM, DM, Wi, DM, 0, 0, DM, 10, smem, [&](int nt, int r, int c, f32x4 v) {
      const int t = t0 + r, gcol = nt * 256 + c;
      u32x2 w; w.x = pk2(v.x, v.y); w.y = pk2(v.z, v.w);
      if (gcol < 1792) *(u32x2*)((bf16_t*)(ws + P_PC) + (size_t)t * 1792 + gcol) = w;
      else if (gcol < 2304) *(u32x2*)((bf16_t*)(ws + P_QD) + (size_t)t * 512 + (gcol - 1792)) = w;
      else if (gcol < 2432) *(u32x2*)((bf16_t*)(ws + P_KD) + (size_t)t * 128 + (gcol - 2304)) = w;
      else {
        const int ts = seq_start(t), S = seq_len(t), pos = t - ts;
        bf16_t* d = (bf16_t*)(ws + P_VTD) + (size_t)ts * 128 + (size_t)(gcol - 2432) * S + pos;
        d[0] = (bf16_t)f2bf(v.x); d[S] = (bf16_t)f2bf(v.y); d[2 * (size_t)S] = (bf16_t)f2bf(v.z); d[3 * (size_t)S] = (bf16_t)f2bf(v.w);
      }
    });
    fence_sync();
  }
}

__device__ void phase7(const Params& p, unsigned char* smem) {
  unsigned char* ws = p.ws;
  bf16_t* Y = (bf16_t*)(ws + WS_Y);
  const bf16_t* PC = (const bf16_t*)(ws + P_PC);
  const bf16_t* YS0 = (const bf16_t*)(ws + WS_YS);
  const bf16_t* YS1 = YS0 + (size_t)T * 512;
  bf16_t* zs = (bf16_t*)(ws + WS_ZG + (size_t)blockIdx.x * (96 * 128 * 2));
  const bf16_t* G2 = (const bf16_t*)(ws + W_G2);
  const bf16_t* Wo = (const bf16_t*)(ws + W_OUTO);
  float* stats = (float*)(smem + 73728);
  for (int sp2 = blockIdx.x; sp2 < NSTRIPE / 2; sp2 += gridDim.x) {
   const int t00 = sp2 * 192;
#pragma unroll 1
   for (int hf = 0; hf < 2; ++hf) {
    const int t0 = t00 + hf * 96;
    const int tid = opaque_tid(), lane = tid & 63, wid = tid >> 6;
    __syncthreads();
    for (int i = tid; i < 96 * 128; i += 256) {
      const int r = i >> 7, c = i & 127, t = t0 + r, ts = seq_start(t), S = seq_len(t), pos = t - ts, col = 1664 + c;
      const float xc = bf2f(PC[(size_t)t * 1792 + col]);
      const float xp = pos > 0 ? bf2f(PC[(size_t)(t - 1) * 1792 + col]) : 0.f;
      const float xn = pos < S - 1 ? bf2f(PC[(size_t)(t + 1) * 1792 + col]) : 0.f;
      const float x = xc + p.in[15][col] * (xp - xc) + p.in[15][1792 + col] * (xn - xc);
      zs[i] = (bf16_t)f2bf(1.0f / (1.0f + expf(-x)));
    }
    fence_sync();
#pragma unroll 1
    for (int nt = 0; nt < 2; ++nt) {
      __syncthreads();
      for (int i = wid; i < 96 * 4; i += 4) {
        const int r = i >> 2, hh = nt * 4 + (i & 3);
        const size_t off = (size_t)(t0 + r) * 512 + hh * 64 + lane;
        const float yv = bf2f(YS0[off]) + bf2f(YS1[off]);
        const float mean = wave_sum(yv) * (1.0f / 64.0f);
        const float d = yv - mean;
        const float var = wave_sum(d * d) * (1.0f / 64.0f);
        if (lane == 0) { stats[i * 2] = mean; stats[i * 2 + 1] = 1.0f / sqrtf(var + 64e-5f); }
      }
      __syncthreads();
      gemm_tile(zs, 128, G2 + (size_t)nt * 256 * 128, 128, 128, smem, [&](int r, int c, f32x4 v) {
        const int t = t0 + r, col = nt * 256 + c, hl = c >> 6;
        const float mean = stats[(r * 4 + hl) * 2], rstd = stats[(r * 4 + hl) * 2 + 1];
        const u32x2 a = *(const u32x2*)(YS0 + (size_t)t * 512 + col), b = *(const u32x2*)(YS1 + (size_t)t * 512 + col);
        const f32x4 yv = (f32x4){bflo(a.x) + bflo(b.x), bfhi(a.x) + bfhi(b.x), bflo(a.y) + bflo(b.y), bfhi(a.y) + bfhi(b.y)};
        const f32x4 lw = *(const f32x4*)(p.in[24] + col), lb = *(const f32x4*)(p.in[25] + col);
        const f32x4 o = ((yv - mean) * rstd * lw + lb) * v;
        u32x2 w; w.x = pk2(o.x, o.y); w.y = pk2(o.z, o.w);
        *(u32x2*)(Y + (size_t)t * DM + col) = w;
      });
    }
   }
    fence_sync();
    gemm192(Y + (size_t)t00 * DM, DM, Wo, DM, 0, 0, DM, 4, smem, [&](int nt, int r, int c, f32x4 v) {
      float* d = p.out + (size_t)(t00 + r) * DM + nt * 256 + c;
      *(f32x4*)d = *(const f32x4*)d + v;
    });
    fence_sync();
    norm_stripe<1>(p, t00, p.in[4] + DM, Y); norm_stripe<1>(p, t00 + 96, p.in[4] + DM, Y);
    fence_sync();
  }
}

__device__ void phase8(const Params& p, unsigned char* smem) {
  unsigned char* ws = p.ws;
  bf16_t* Y = (bf16_t*)(ws + WS_Y);
  bf16_t* hid = (bf16_t*)(ws + WS_P + (size_t)blockIdx.x * (2 * HID_BLK));
  for (int sp = blockIdx.x; sp < NSTRIPE / 2; sp += gridDim.x) {
    const int t0 = sp * 192;
    ffn_stripe<1, 2>(p, t0, smem, Y, hid);
    norm_stripe<2>(p, t0, p.in[5], nullptr); norm_stripe<2>(p, t0 + 96, p.in[5], nullptr);
    fence_sync();
  }
}

#ifndef PHMASK
#define PHMASK 0x1ff
#endif
#define PH_ON(k) (((PHMASK) >> (k)) & 1)
#ifndef REPEAT_PH
#define REPEAT_PH -1
#endif
__global__ void __launch_bounds__(256, 2) mega(Params p) {
  __shared__ __attribute__((aligned(16))) unsigned char smem[SMEM_BYTES];
  cg::grid_group grid = cg::this_grid();
  unsigned* ctr = (unsigned*)(p.ws + WS_CTL);
  const int lo = p.ph_lo, hi = p.ph_hi;
#define IN(k) (PH_ON(k) && lo <= (k) && (k) < hi)
#define SEAM(k) do { if (lo <= (k) && (k) + 1 < hi) grid.sync(); } while (0)
  if (IN(0)) phase0(p, smem);
#if REPEAT_PH == 0
  grid.sync(); phase0(p, smem);
#endif
  SEAM(0);
  if (IN(1)) phase1(p, smem);
#if REPEAT_PH == 1
  grid.sync(); phase1(p, smem);
#endif
  SEAM(1);
  if (IN(2)) {
    for (;;) {
      const int it = next_item(ctr + 0, smem);
      if (it >= 2048 + 3072 + 4096) break;
      if (it >= 2048 && it < 2048 + 3072) retU_item(p, it - 2048, smem);
      else diff_item(p, it < 2048 ? it : it - 3072, smem);
    }
  }
#if REPEAT_PH == 2
  grid.sync();
  for (;;) {
    const int it = next_item(ctr + 128, smem);
    if (it >= 2048 + 3072 + 4096) break;
    if (it >= 2048 && it < 2048 + 3072) retU_item(p, it - 2048, smem);
    else diff_item(p, it < 2048 ? it : it - 3072, smem);
  }
#endif
  SEAM(2);
  if (IN(3)) ret_scan(p);
  SEAM(3);
  if (IN(4)) for (int it = blockIdx.x; it < 3072; it += gridDim.x) retO_item(p, it, smem);
#if REPEAT_PH == 4
  grid.sync(); for (int it = blockIdx.x; it < 3072; it += gridDim.x) retO_item(p, it, smem);
#endif
  SEAM(4);
  if (IN(5)) phase5(p, smem);
  SEAM(5);
  if (IN(6)) {
    for (;;) {
      const int it = next_item(ctr + 64, smem);
      if (it >= 512 + 512 + 3072) break;
      if (it < 512) rwkv_chain<false>(p, it & 1, 2 + (it >> 4), (it >> 1) & 7, 0, 128, 0, nullptr, nullptr, nullptr, smem);
      else if (it < 1024) {
        const int i3 = it - 512, z = i3 & 1, h = (i3 >> 1) & 7, sg = (i3 >> 4) & 15, seq = i3 >> 8, ch = (seq * 8 + h) * 2 + z;
        float* dL = (float*)(p.ws + WS_RL) + ((size_t)ch * 16 + sg) * 4096;
        float* dP = (float*)(p.ws + WS_RPHI) + ((size_t)ch * 16 + sg) * 4096;
        rwkv_chain<true>(p, z, seq, h, sg * 64, sg * 64 + 64, 1, nullptr, dL, dP, smem);
      } else swa_item(p, it - 1024, smem);
    }
    grid.sync();
    if (blockIdx.x < 32) rwkv_combine(p, blockIdx.x, smem);
    grid.sync();
    for (int it = blockIdx.x; it < 512; it += gridDim.x) {
      const int z = it & 1, h = (it >> 1) & 7, sg = (it >> 4) & 15, seq = it >> 8, ch = (seq * 8 + h) * 2 + z;
      rwkv_chain<false>(p, z, seq, h, sg * 64, sg * 64 + 64, 3, (const float*)(p.ws + WS_RS) + ((size_t)ch * 16 + sg) * 4096, nullptr, nullptr, smem);
    }
  }
#if REPEAT_PH == 6
  grid.sync();
  {
    for (;;) {
      const int it = next_item(ctr + 192, smem);
      if (it >= 512 + 512 + 3072) break;
      if (it < 512) rwkv_chain<false>(p, it & 1, 2 + (it >> 4), (it >> 1) & 7, 0, 128, 0, nullptr, nullptr, nullptr, smem);
      else if (it < 1024) {
        const int i3 = it - 512, z = i3 & 1, h = (i3 >> 1) & 7, sg = (i3 >> 4) & 15, seq = i3 >> 8, ch = (seq * 8 + h) * 2 + z;
        float* dL = (float*)(p.ws + WS_RL) + ((size_t)ch * 16 + sg) * 4096;
        float* dP = (float*)(p.ws + WS_RPHI) + ((size_t)ch * 16 + sg) * 4096;
        rwkv_chain<true>(p, z, seq, h, sg * 64, sg * 64 + 64, 1, nullptr, dL, dP, smem);
      } else swa_item(p, it - 1024, smem);
    }
    grid.sync();
    if (blockIdx.x < 32) rwkv_combine(p, blockIdx.x, smem);
    grid.sync();
    for (int it = blockIdx.x; it < 512; it += gridDim.x) {
      const int z = it & 1, h = (it >> 1) & 7, sg = (it >> 4) & 15, seq = it >> 8, ch = (seq * 8 + h) * 2 + z;
      rwkv_chain<false>(p, z, seq, h, sg * 64, sg * 64 + 64, 3, (const float*)(p.ws + WS_RS) + ((size_t)ch * 16 + sg) * 4096, nullptr, nullptr, smem);
    }
  }
#endif
  SEAM(6);
  if (IN(7)) phase7(p, smem);
  SEAM(7);
  if (IN(8)) phase8(p, smem);
#undef IN
#undef SEAM
}

extern "C" void kernel_launch(void* const* d_in, const int* in_sizes, int n_in, void* d_out, int out_size, void* d_ws, size_t ws_size, hipStream_t stream) {
  static int grid_blocks = 0;
  if (!grid_blocks) {
    if (n_in != 27 || out_size != T * DM || ws_size < WS_END + 40 * MiB) { fprintf(stderr, "kernel_launch: unexpected shapes (n_in %d out %d ws %zu)\n", n_in, out_size, ws_size); grid_blocks = -1; return; }
    int dev = 0, cus = 0, per_cu = 0;
    hipGetDevice(&dev);
    hipDeviceGetAttribute(&cus, hipDeviceAttributeMultiprocessorCount, dev);
    hipOccupancyMaxActiveBlocksPerMultiprocessor(&per_cu, mega, 256, 0);
    if (per_cu < 1) per_cu = 1;
    if (per_cu > 2) per_cu = 2;
    grid_blocks = cus * per_cu;
    if (grid_blocks > MAXGRID) grid_blocks = MAXGRID;
  }
  if (grid_blocks < 0) return;
  hipMemsetAsync((char*)d_ws + WS_CTL, 0, 4096, stream);
  Params p{};
  for (int i = 0; i < 27; ++i) p.in[i] = (const float*)d_in[i];
  p.out = (float*)d_out; p.ws = (unsigned char*)d_ws;
#define ONE_LAUNCH 1
#if !ONE_LAUNCH
#ifndef MAXPH
#define MAXPH 9
#endif
  for (int ph = 0; ph < MAXPH; ++ph) {
    p.ph_lo = ph; p.ph_hi = ph + 1;
    void* args[] = {&p};
    hipError_t e = hipLaunchCooperativeKernel((void*)mega, dim3(grid_blocks), dim3(256), args, 0, stream);
    if (e != hipSuccess) { fprintf(stderr, "launch %d failed: %s\n", ph, hipGetErrorString(e)); break; }
  }
#else
  p.ph_lo = 0; p.ph_hi = 9;
  void* args[] = {&p};
  hipError_t e = hipLaunchCooperativeKernel((void*)mega, dim3(grid_blocks), dim3(256), args, 0, stream);
  if (e != hipSuccess) fprintf(stderr, "cooperative launch failed: %s (grid %d)\n", hipGetErrorString(e), grid_blocks);
#endif
}
```
